# Optimizing an MI355X kernel written in HIP

```python
import math
import jax, jax.numpy as jnp
from jax import lax
import numpy as np

D_MODEL = 2048
BATCH = 4
SEQ = 2048
DEPTH = 1
DEC_BATCH = 128
DEC_SEQ = 8
PAST_LEN = 16384
PAGE_SIZE = 128

MIX_WIDTH = D_MODEL
S5_WIDTH = MIX_WIDTH // 2
S5_GROUP = 16
S5_GROUPS = S5_WIDTH // S5_GROUP
S5_STATE = 64
RET_WIDTH = MIX_WIDTH - S5_WIDTH
RET_HEADS = 8
RET_HEAD_DIM = RET_WIDTH // RET_HEADS
RET_CHUNK = 128
ROPE_BASE = 10000.0
D_FF = ((8 * D_MODEL + 2) // 3 + 255) // 256 * 256
IN_WIDTH = S5_WIDTH + 4 * RET_WIDTH
NORM_EPS = 1e-6

kernel_name = "hybrid_s5_retention_decode_step"


def rms_norm(x, g):
    xf = x.astype(jnp.float32)
    y = xf * lax.rsqrt(jnp.mean(xf * xf, axis=-1, keepdims=True) + NORM_EPS)
    return (y * g.astype(jnp.float32)).astype(x.dtype)


def rotary(x, pos):
    half = x.shape[-1] // 2
    inv_freq = ROPE_BASE ** (-jnp.arange(half, dtype=jnp.float32) / half)
    ang = pos[:, None] * inv_freq[None, :]
    cos, sin = jnp.cos(ang), jnp.sin(ang)
    x1, x2 = x[..., :half], x[..., half:]
    return jnp.concatenate([x1 * cos - x2 * sin, x1 * sin + x2 * cos], axis=-1)


def _lin_combine(e_i, e_j):
    a_i, b_i = e_i
    a_j, b_j = e_j
    return a_j * a_i, a_j * b_i + b_j


def s5_mixer(u, x0_re, x0_im, lam_re, lam_im, log_step, b_re, b_im, c_re, c_im, d, w_glu, b_glu):
    n, l, _ = u.shape
    f32 = jnp.float32
    lam = lax.complex(lam_re.astype(f32), lam_im.astype(f32))
    dt = jnp.exp(log_step.astype(f32))
    lam_dt = lam * dt[:, None]
    lam_bar = jnp.exp(lam_dt)
    b = lax.complex(b_re.astype(f32), b_im.astype(f32))
    b_bar = ((lam_bar - 1.0) / lam)[..., None] * b
    c = lax.complex(c_re.astype(f32), c_im.astype(f32))
    uf = u.astype(f32)
    ug = uf.reshape(n, l, S5_GROUPS, S5_GROUP)
    bu = jnp.einsum('nlgh,gph->lngp', ug.astype(jnp.complex64), b_bar)
    x0 = lax.complex(x0_re.astype(f32), x0_im.astype(f32))
    bu = bu.at[0].add(lam_bar[None] * x0)
    a = jnp.broadcast_to(lam_bar, (l, 1, S5_GROUPS, S5_STATE))
    _, xs = lax.associative_scan(_lin_combine, (a, bu), axis=0)
    y = jnp.einsum('lngp,ghp->nlgh', xs, c).real.reshape(n, l, S5_WIDTH)
    y = y + d.astype(f32) * uf
    y = jax.nn.gelu(y)
    y = y * jax.nn.sigmoid(y @ w_glu.astype(f32) + b_glu.astype(f32))
    x_last = xs[-1]
    return y.astype(u.dtype), jnp.real(x_last), jnp.imag(x_last)


def retention_chunked(q, k, v, r0):
    n, h, l, dk = q.shape
    dv = v.shape[-1]
    chunk = math.gcd(l, RET_CHUNK)
    nc = l // chunk
    log_gamma = jnp.log(1.0 - 2.0 ** (-5.0 - jnp.arange(h, dtype=jnp.float32)))
    idx = jnp.arange(chunk, dtype=jnp.float32)
    diff = idx[:, None] - idx[None, :]
    mask = jnp.where(diff >= 0, jnp.exp(log_gamma[:, None, None] * jnp.maximum(diff, 0.0)), 0.0)
    q_decay = jnp.exp(log_gamma[:, None] * (idx + 1.0))[..., None]
    k_decay = jnp.exp(log_gamma[:, None] * (chunk - 1.0 - idx))[..., None]
    chunk_decay = jnp.exp(log_gamma * chunk)[:, None, None]

    def to_chunks(t):
        return t.reshape(n, h, nc, chunk, t.shape[-1]).transpose(2, 0, 1, 3, 4)

    def step(r, inp):
        qc, kc, vc = inp
        scores = jnp.einsum('bhnd,bhmd->bhnm', qc, kc) * mask
        o = jnp.einsum('bhnm,bhme->bhne', scores, vc) + jnp.einsum('bhnd,bhde->bhne', qc, r) * q_decay
        r_new = r * chunk_decay + jnp.einsum('bhmd,bhme->bhde', kc * k_decay, vc)
        return r_new, o

    r_last, o = lax.scan(step, r0, (to_chunks(q), to_chunks(k), to_chunks(v)))
    o = o.transpose(1, 2, 0, 3, 4).reshape(n, h, l, dv)
    return o, r_last


def hybrid_layer(x, s5_re0, s5_im0, ret0, pos0,
                 norm_mix, w_in, lam_re, lam_im, log_step, b_re, b_im, c_re, c_im, d, w_glu, b_glu,
                 ret_gn_w, w_out, norm_ffn, w_ffn_in, w_ffn_out):
    n, l, _ = x.shape
    f32 = jnp.float32
    h = rms_norm(x, norm_mix)
    proj = h @ w_in
    u, q, k, v, g = jnp.split(proj, [S5_WIDTH, S5_WIDTH + RET_WIDTH, S5_WIDTH + 2 * RET_WIDTH,
                                     S5_WIDTH + 3 * RET_WIDTH], axis=-1)
    s5_out, s5_re, s5_im = s5_mixer(u, s5_re0, s5_im0, lam_re, lam_im, log_step,
                                    b_re, b_im, c_re, c_im, d, w_glu, b_glu)
    def heads(t):
        return t.astype(f32).reshape(n, l, RET_HEADS, RET_HEAD_DIM).transpose(0, 2, 1, 3)
    pos = pos0 + jnp.arange(l, dtype=f32)
    qh = rotary(heads(q), pos)
    kh = rotary(heads(k), pos) * (RET_HEAD_DIM ** -0.5)
    vh = heads(v)
    o, ret_new = retention_chunked(qh, kh, vh, ret0.astype(f32))
    mu = jnp.mean(o, axis=-1, keepdims=True)
    var = jnp.mean(jnp.square(o - mu), axis=-1, keepdims=True)
    o = (o - mu) * lax.rsqrt(var + NORM_EPS)
    o = o.transpose(0, 2, 1, 3).reshape(n, l, RET_WIDTH) * ret_gn_w.astype(f32)
    ret_out = (jax.nn.silu(g.astype(f32)) * o).astype(x.dtype)
    x = x + jnp.concatenate([s5_out, ret_out], axis=-1) @ w_out
    h2 = rms_norm(x, norm_ffn)
    gate, up = jnp.split(h2 @ w_ffn_in, 2, axis=-1)
    x = x + (jax.nn.silu(gate) * up) @ w_ffn_out
    return x, s5_re, s5_im, ret_new


def setup_inputs(seed: int = 0) -> dict:
    key = jax.random.key(seed)
    ks = jax.random.split(key, 24)
    nrm = jax.random.normal
    n_idx = jnp.arange(S5_STATE, dtype=jnp.float32)
    return {
        "x_prompt": nrm(ks[0], (BATCH, SEQ, D_MODEL), jnp.float32),
        "x_sample": nrm(ks[1], (DEC_BATCH, DEC_SEQ, D_MODEL), jnp.float32),
        "state_s5_re": 0.5 * nrm(ks[2], (DEPTH, DEC_BATCH, S5_GROUPS, S5_STATE), jnp.float32),
        "state_s5_im": 0.5 * nrm(ks[3], (DEPTH, DEC_BATCH, S5_GROUPS, S5_STATE), jnp.float32),
        "state_ret": 0.5 * nrm(ks[4], (DEPTH, DEC_BATCH, RET_HEADS, RET_HEAD_DIM, RET_HEAD_DIM), jnp.float32),
        "norm_mix": 1.0 + 0.02 * nrm(ks[5], (DEPTH, D_MODEL), jnp.float32),
        "w_in": nrm(ks[6], (DEPTH, D_MODEL, IN_WIDTH), jnp.float32) * D_MODEL ** -0.5,
        "s5_lambda_re": -0.5 + 0.01 * nrm(ks[7], (DEPTH, S5_GROUPS, S5_STATE), jnp.float32),
        "s5_lambda_im": math.pi * n_idx + 0.01 * nrm(ks[8], (DEPTH, S5_GROUPS, S5_STATE), jnp.float32),
        "s5_log_step": jax.random.uniform(ks[9], (DEPTH, S5_GROUPS), jnp.float32,
                                          minval=math.log(1e-3), maxval=math.log(1e-1)),
        "s5_b_re": nrm(ks[10], (DEPTH, S5_GROUPS, S5_STATE, S5_GROUP), jnp.float32) * (2 * S5_GROUP) ** -0.5,
        "s5_b_im": nrm(ks[11], (DEPTH, S5_GROUPS, S5_STATE, S5_GROUP), jnp.float32) * (2 * S5_GROUP) ** -0.5,
        "s5_c_re": 0.5 * nrm(ks[12], (DEPTH, S5_GROUPS, S5_GROUP, S5_STATE), jnp.float32),
        "s5_c_im": 0.5 * nrm(ks[13], (DEPTH, S5_GROUPS, S5_GROUP, S5_STATE), jnp.float32),
        "s5_d": nrm(ks[14], (DEPTH, S5_WIDTH), jnp.float32),
        "s5_w_glu": nrm(ks[15], (DEPTH, S5_WIDTH, S5_WIDTH), jnp.float32) * S5_WIDTH ** -0.5,
        "s5_b_glu": 0.02 * nrm(ks[16], (DEPTH, S5_WIDTH), jnp.float32),
        "ret_gn_w": 1.0 + 0.02 * nrm(ks[17], (DEPTH, RET_WIDTH), jnp.float32),
        "w_out": nrm(ks[18], (DEPTH, MIX_WIDTH, D_MODEL), jnp.float32) * MIX_WIDTH ** -0.5,
        "norm_ffn": 1.0 + 0.02 * nrm(ks[19], (DEPTH, D_MODEL), jnp.float32),
        "w_ffn_in": nrm(ks[20], (DEPTH, D_MODEL, 2 * D_FF), jnp.float32) * D_MODEL ** -0.5,
        "w_ffn_out": nrm(ks[21], (DEPTH, D_FF, D_MODEL), jnp.float32) * D_FF ** -0.5,
        "norm_final": 1.0 + 0.02 * nrm(ks[22], (D_MODEL,), jnp.float32),
    }


def reference(x_prompt, x_sample, state_s5_re, state_s5_im, state_ret,
              norm_mix, w_in, s5_lambda_re, s5_lambda_im, s5_log_step, s5_b_re, s5_b_im,
              s5_c_re, s5_c_im, s5_d, s5_w_glu, s5_b_glu, ret_gn_w, w_out, norm_ffn,
              w_ffn_in, w_ffn_out, norm_final):
    f32 = jnp.float32
    xp, xs = x_prompt, x_sample
    p_re, p_im, p_ret, s_re, s_im, s_ret = [], [], [], [], [], []
    zero_s5 = jnp.zeros((x_prompt.shape[0], S5_GROUPS, S5_STATE), f32)
    zero_ret = jnp.zeros((x_prompt.shape[0], RET_HEADS, RET_HEAD_DIM, RET_HEAD_DIM), f32)
    for li in range(DEPTH):
        weights = (norm_mix[li], w_in[li], s5_lambda_re[li], s5_lambda_im[li], s5_log_step[li],
                   s5_b_re[li], s5_b_im[li], s5_c_re[li], s5_c_im[li], s5_d[li], s5_w_glu[li],
                   s5_b_glu[li], ret_gn_w[li], w_out[li], norm_ffn[li], w_ffn_in[li], w_ffn_out[li])
        xp, pre, pim, pr = hybrid_layer(xp, zero_s5, zero_s5, zero_ret, jnp.float32(0.0), *weights)
        xs, sre, sim, sr = hybrid_layer(xs, state_s5_re[li], state_s5_im[li], state_ret[li],
                                        jnp.float32(PAST_LEN), *weights)
        p_re.append(pre); p_im.append(pim); p_ret.append(pr)
        s_re.append(sre); s_im.append(sim); s_ret.append(sr)
    y_prompt = rms_norm(xp, norm_final)
    y_sample = rms_norm(xs, norm_final)
    return (y_prompt, y_sample,
            jnp.stack(p_re), jnp.stack(p_im), jnp.stack(p_ret),
            jnp.stack(s_re), jnp.stack(s_im), jnp.stack(s_ret))
```

```cpp
#include <hip/hip_runtime.h>
#include <math.h>

constexpr int D_MODEL = 2048, BATCH = 4, SEQ = 2048, DEC_BATCH = 128, DEC_SEQ = 8;
constexpr float PAST_LEN = 16384.f;
constexpr int S5_WIDTH = 1024, RET_WIDTH = 1024, HD = 128;
constexpr int D_FF = 5632, IN_WIDTH = 5120;
constexpr int MP = BATCH * SEQ, MS = DEC_BATCH * DEC_SEQ, M = MP + MS;
constexpr float NORM_EPS = 1e-6f;

__global__ void __launch_bounds__(256) k_rmsnorm(const float* x, const float* g, float* out) {
    __shared__ float red[4];
    const int row = blockIdx.x, tid = threadIdx.x;
    const float* xr = x + (size_t)row * D_MODEL;
    float v[8]; float ss = 0.f;
#pragma unroll
    for (int i = 0; i < 8; ++i) { v[i] = xr[tid + 256 * i]; ss += v[i] * v[i]; }
#pragma unroll
    for (int o = 1; o < 64; o <<= 1) ss += __shfl_xor(ss, o);
    if ((tid & 63) == 0) red[tid >> 6] = ss;
    __syncthreads();
    const float tot = red[0] + red[1] + red[2] + red[3];
    const float s = rsqrtf(tot * (1.f / D_MODEL) + NORM_EPS);
    float* orow = out + (size_t)row * D_MODEL;
#pragma unroll
    for (int i = 0; i < 8; ++i) orow[tid + 256 * i] = v[i] * s * g[tid + 256 * i];
}

template <int MODE>
__global__ void __launch_bounds__(256) k_gemm(const float* A, int lda, const float* B, int ldb, float* C, int ldc, int K,
                                             const float* aux, int ldaux, const float* bias, int N2) {
    __shared__ float As[16][68], Bs[16][68], Bs2[MODE == 2 ? 16 : 1][68];
    const int tid = threadIdx.x, tx = tid & 15, ty = tid >> 4;
    const int row0 = blockIdx.y * 64, col0 = blockIdx.x * 64;
    float acc[4][4], acc2[4][4];
#pragma unroll
    for (int i = 0; i < 4; ++i)
#pragma unroll
        for (int j = 0; j < 4; ++j) { acc[i][j] = 0.f; acc2[i][j] = 0.f; }
    const int ar = tid >> 2, ak = (tid & 3) * 4;
    const int bk = tid >> 4, bc = (tid & 15) * 4;
    for (int k0 = 0; k0 < K; k0 += 16) {
        const float4 av = *(const float4*)(A + (size_t)(row0 + ar) * lda + k0 + ak);
        As[ak + 0][ar] = av.x; As[ak + 1][ar] = av.y; As[ak + 2][ar] = av.z; As[ak + 3][ar] = av.w;
        const float4 bv = *(const float4*)(B + (size_t)(k0 + bk) * ldb + col0 + bc);
        *(float4*)&Bs[bk][bc] = bv;
        if (MODE == 2) { const float4 bv2 = *(const float4*)(B + (size_t)(k0 + bk) * ldb + N2 + col0 + bc); *(float4*)&Bs2[bk][bc] = bv2; }
        __syncthreads();
#pragma unroll
        for (int k = 0; k < 16; ++k) {
            const float4 a4 = *(const float4*)&As[k][ty * 4];
            const float4 b4 = *(const float4*)&Bs[k][tx * 4];
            const float a[4] = {a4.x, a4.y, a4.z, a4.w}, b[4] = {b4.x, b4.y, b4.z, b4.w};
#pragma unroll
            for (int i = 0; i < 4; ++i)
#pragma unroll
                for (int j = 0; j < 4; ++j) acc[i][j] += a[i] * b[j];
            if (MODE == 2) {
                const float4 c4 = *(const float4*)&Bs2[k][tx * 4];
                const float c[4] = {c4.x, c4.y, c4.z, c4.w};
#pragma unroll
                for (int i = 0; i < 4; ++i)
#pragma unroll
                    for (int j = 0; j < 4; ++j) acc2[i][j] += a[i] * c[j];
            }
        }
        __syncthreads();
    }
#pragma unroll
    for (int i = 0; i < 4; ++i) {
        const int row = row0 + ty * 4 + i;
#pragma unroll
        for (int j = 0; j < 4; ++j) {
            const int col = col0 + tx * 4 + j;
            float v = acc[i][j];
            float* cp = C + (size_t)row * ldc + col;
            if (MODE == 1) v = *cp + v;
            if (MODE == 2) { const float gte = v; v = gte / (1.f + expf(-gte)) * acc2[i][j]; }
            if (MODE == 3) { const float y = aux[(size_t)row * ldaux + col]; v = y / (1.f + expf(-(v + bias[col]))); }
            *cp = v;
        }
    }
}

__global__ void k_s5_prep(const float* lre, const float* lim, const float* lstep, const float* bre, const float* bim,
                          float* lbr, float* lbi, float* bbr, float* bbi) {
    const int i = blockIdx.x * blockDim.x + threadIdx.x;
    if (i >= 64 * 64) return;
    const int g = i >> 6;
    const double dt = exp((double)lstep[g]);
    const double lr = lre[i], li = lim[i];
    const double er = exp(lr * dt), cr = er * cos(li * dt), ci = er * sin(li * dt);
    lbr[i] = (float)cr; lbi[i] = (float)ci;
    const double nr = cr - 1.0, ni = ci, den = lr * lr + li * li;
    const double fr = (nr * lr + ni * li) / den, fi = (ni * lr - nr * li) / den;
    for (int h = 0; h < 16; ++h) {
        const double br = bre[i * 16 + h], bi = bim[i * 16 + h];
        bbr[i * 16 + h] = (float)(fr * br - fi * bi);
        bbi[i * 16 + h] = (float)(fr * bi + fi * br);
    }
}

__global__ void __launch_bounds__(64) k_s5_naive(const float* proj, int row_base, int L, const float* x0re, const float* x0im,
                                                const float* lbr, const float* lbi, const float* bbr, const float* bbi,
                                                const float* cre, const float* cim, const float* dvec, float* ys5,
                                                float* out_re, float* out_im) {
    const int g = blockIdx.x, n = blockIdx.y, p = threadIdx.x;
    float Br[16], Bi[16], Cr[16], Ci[16];
#pragma unroll
    for (int h = 0; h < 16; ++h) {
        Br[h] = bbr[(g * 64 + p) * 16 + h]; Bi[h] = bbi[(g * 64 + p) * 16 + h];
        Cr[h] = cre[(g * 16 + h) * 64 + p]; Ci[h] = cim[(g * 16 + h) * 64 + p];
    }
    const float lr = lbr[g * 64 + p], li = lbi[g * 64 + p];
    float xr = x0re ? x0re[((size_t)n * 64 + g) * 64 + p] : 0.f;
    float xi = x0im ? x0im[((size_t)n * 64 + g) * 64 + p] : 0.f;
    const float dmy = (p < 16) ? dvec[g * 16 + p] : 0.f;
    for (int t = 0; t < L; ++t) {
        const size_t row = (size_t)row_base + (size_t)n * L + t;
        const float* u = proj + row * IN_WIDTH + g * 16;
        float bur = 0.f, bui = 0.f;
#pragma unroll
        for (int h = 0; h < 16; ++h) { const float uh = u[h]; bur += Br[h] * uh; bui += Bi[h] * uh; }
        const float nxr = lr * xr - li * xi + bur, nxi = lr * xi + li * xr + bui;
        xr = nxr; xi = nxi;
        float myy = 0.f;
#pragma unroll
        for (int h = 0; h < 16; ++h) {
            float v = xr * Cr[h] - xi * Ci[h];
#pragma unroll
            for (int o = 1; o < 64; o <<= 1) v += __shfl_xor(v, o);
            if (p == h) myy = v;
        }
        if (p < 16) {
            float y = myy + dmy * u[p];
            const float c = 0.7978845608028654f * (y + 0.044715f * y * y * y);
            y = 0.5f * y * (1.f + tanhf(c));
            ys5[row * S5_WIDTH + g * 16 + p] = y;
        }
    }
    out_re[((size_t)n * 64 + g) * 64 + p] = xr;
    out_im[((size_t)n * 64 + g) * 64 + p] = xi;
}

__global__ void __launch_bounds__(256) k_ret_naive(const float* proj, int row_base, int L, float pos0, const float* r0, const float* gnw,
                                                  float* mix, float* r_out) {
    __shared__ float qs[128], ks[128], part[2][128], red[4];
    const int h = blockIdx.x, n = blockIdx.y, tid = threadIdx.x, e = tid & 127, dh = tid >> 7;
    float R[64];
    const size_t rbase = ((size_t)n * 8 + h) * 128 * 128;
#pragma unroll
    for (int dd = 0; dd < 64; ++dd) R[dd] = r0 ? r0[rbase + (size_t)(64 * dh + dd) * 128 + e] : 0.f;
    const float gamma = 1.f - exp2f(-5.f - (float)h);
    const float gw = gnw[h * 128 + e];
    for (int t = 0; t < L; ++t) {
        const size_t row = (size_t)row_base + (size_t)n * L + t;
        const float* pr = proj + row * IN_WIDTH;
        if (tid < 128) {
            const int j = tid & 63;
            const float inv = powf(10000.f, -(float)j / 64.f);
            const float ang = (pos0 + (float)t) * inv;
            float sn, cs; sincosf(ang, &sn, &cs);
            const float q1 = pr[1024 + h * 128 + j], q2 = pr[1024 + h * 128 + 64 + j];
            const float k1 = pr[2048 + h * 128 + j], k2 = pr[2048 + h * 128 + 64 + j];
            qs[tid] = (tid < 64) ? (q1 * cs - q2 * sn) : (q1 * sn + q2 * cs);
            ks[tid] = ((tid < 64) ? (k1 * cs - k2 * sn) : (k1 * sn + k2 * cs)) * 0.08838834764831845f;
        }
        const float ve = pr[3072 + h * 128 + e];
        __syncthreads();
        float partial = 0.f;
#pragma unroll
        for (int dd = 0; dd < 64; ++dd) {
            const int d = 64 * dh + dd;
            R[dd] = gamma * R[dd] + ks[d] * ve;
            partial += qs[d] * R[dd];
        }
        part[dh][e] = partial;
        __syncthreads();
        float o = part[0][e] + part[1][e];
        float s = o;
#pragma unroll
        for (int of = 1; of < 64; of <<= 1) s += __shfl_xor(s, of);
        if ((tid & 63) == 0) red[tid >> 6] = s;
        __syncthreads();
        const float mu = (red[0] + red[1]) * (1.f / 128.f);
        __syncthreads();
        const float dlt = o - mu;
        float s2 = dlt * dlt;
#pragma unroll
        for (int of = 1; of < 64; of <<= 1) s2 += __shfl_xor(s2, of);
        if ((tid & 63) == 0) red[tid >> 6] = s2;
        __syncthreads();
        const float var = (red[0] + red[1]) * (1.f / 128.f);
        if (tid < 128) {
            const float gt = pr[4096 + h * 128 + e];
            const float sg = gt / (1.f + expf(-gt));
            mix[row * D_MODEL + 1024 + h * 128 + e] = sg * (dlt * rsqrtf(var + NORM_EPS) * gw);
        }
        __syncthreads();
    }
#pragma unroll
    for (int dd = 0; dd < 64; ++dd) r_out[rbase + (size_t)(64 * dh + dd) * 128 + e] = R[dd];
}

extern "C" void kernel_launch(void* const* d_in, const int* in_sizes, int n_in, void* d_out, int out_size, void* d_ws, size_t ws_size,
                              hipStream_t stream) {
    const float* x_prompt = (const float*)d_in[0];
    const float* x_sample = (const float*)d_in[1];
    const float* st_re = (const float*)d_in[2];
    const float* st_im = (const float*)d_in[3];
    const float* st_ret = (const float*)d_in[4];
    const float* norm_mix = (const float*)d_in[5];
    const float* w_in = (const float*)d_in[6];
    const float* lam_re = (const float*)d_in[7];
    const float* lam_im = (const float*)d_in[8];
    const float* log_step = (const float*)d_in[9];
    const float* b_re = (const float*)d_in[10];
    const float* b_im = (const float*)d_in[11];
    const float* c_re = (const float*)d_in[12];
    const float* c_im = (const float*)d_in[13];
    const float* s5_d = (const float*)d_in[14];
    const float* w_glu = (const float*)d_in[15];
    const float* b_glu = (const float*)d_in[16];
    const float* gn_w = (const float*)d_in[17];
    const float* w_out = (const float*)d_in[18];
    const float* norm_ffn = (const float*)d_in[19];
    const float* w_ffn_in = (const float*)d_in[20];
    const float* w_ffn_out = (const float*)d_in[21];
    const float* norm_final = (const float*)d_in[22];

    float* out = (float*)d_out;
    float* Y = out;
    float* o_s5re_p = out + (size_t)M * D_MODEL;
    float* o_s5im_p = o_s5re_p + 4 * 64 * 64;
    float* o_ret_p = o_s5im_p + 4 * 64 * 64;
    float* o_s5re_s = o_ret_p + (size_t)4 * 8 * 128 * 128;
    float* o_s5im_s = o_s5re_s + (size_t)128 * 64 * 64;
    float* o_ret_s = o_s5im_s + (size_t)128 * 64 * 64;

    float* ws = (float*)d_ws;
    float* H = ws;
    float* PROJ = H + (size_t)M * D_MODEL;
    float* YS5 = PROJ + (size_t)M * D_FF;
    float* PAR = YS5 + (size_t)M * S5_WIDTH;
    float* lbr = PAR, *lbi = PAR + 4096, *bbr = PAR + 8192, *bbi = PAR + 8192 + 65536;
    float* MIX = H;

    hipMemcpyAsync(Y, x_prompt, (size_t)MP * D_MODEL * 4, hipMemcpyDeviceToDevice, stream);
    hipMemcpyAsync(Y + (size_t)MP * D_MODEL, x_sample, (size_t)MS * D_MODEL * 4, hipMemcpyDeviceToDevice, stream);
    k_rmsnorm<<<M, 256, 0, stream>>>(Y, norm_mix, H);
    k_gemm<0><<<dim3(IN_WIDTH / 64, M / 64), 256, 0, stream>>>(H, D_MODEL, w_in, IN_WIDTH, PROJ, IN_WIDTH, D_MODEL, nullptr, 0, nullptr, 0);
    k_s5_prep<<<16, 256, 0, stream>>>(lam_re, lam_im, log_step, b_re, b_im, lbr, lbi, bbr, bbi);
    k_s5_naive<<<dim3(64, BATCH), 64, 0, stream>>>(PROJ, 0, SEQ, nullptr, nullptr, lbr, lbi, bbr, bbi, c_re, c_im, s5_d, YS5, o_s5re_p, o_s5im_p);
    k_s5_naive<<<dim3(64, DEC_BATCH), 64, 0, stream>>>(PROJ, MP, DEC_SEQ, st_re, st_im, lbr, lbi, bbr, bbi, c_re, c_im, s5_d, YS5, o_s5re_s, o_s5im_s);
    k_ret_naive<<<dim3(8, BATCH), 256, 0, stream>>>(PROJ, 0, SEQ, 0.f, nullptr, gn_w, MIX, o_ret_p);
    k_ret_naive<<<dim3(8, DEC_BATCH), 256, 0, stream>>>(PROJ, MP, DEC_SEQ, PAST_LEN, st_ret, gn_w, MIX, o_ret_s);
    k_gemm<3><<<dim3(S5_WIDTH / 64, M / 64), 256, 0, stream>>>(YS5, S5_WIDTH, w_glu, S5_WIDTH, MIX, D_MODEL, S5_WIDTH, YS5, S5_WIDTH, b_glu, 0);
    k_gemm<1><<<dim3(D_MODEL / 64, M / 64), 256, 0, stream>>>(MIX, D_MODEL, w_out, D_MODEL, Y, D_MODEL, D_MODEL, nullptr, 0, nullptr, 0);
    k_rmsnorm<<<M, 256, 0, stream>>>(Y, norm_ffn, H);
    k_gemm<2><<<dim3(D_FF / 64, M / 64), 256, 0, stream>>>(H, D_MODEL, w_ffn_in, 2 * D_FF, PROJ, D_FF, D_MODEL, nullptr, 0, nullptr, D_FF);
    k_gemm<1><<<dim3(D_MODEL / 64, M / 64), 256, 0, stream>>>(PROJ, D_FF, w_ffn_out, D_MODEL, Y, D_MODEL, D_FF, nullptr, 0, nullptr, 0);
    k_rmsnorm<<<M, 256, 0, stream>>>(Y, norm_final, Y);
}
```

```cpp
#include <hip/hip_runtime.h>
#include <cstdio>
#include <cstdint>
#include <math.h>
#ifndef MK_N_LAUNCHES
#define MK_N_LAUNCHES 1
#endif
constexpr int N_LAUNCHES = MK_N_LAUNCHES;
constexpr int N_PHASES = 9;
constexpr int NWAVES = 8;
constexpr int MROWS = 9216;
constexpr size_t MiB = 1u << 20;
constexpr size_t WS_CTL = 0, CTL_ZERO_BYTES = 72 * 1024;
constexpr size_t WS_PAR = 1 * MiB;
constexpr size_t WS_WIN = 4 * MiB, WS_WGLU = 24 * MiB, WS_WOUT = 26 * MiB, WS_WFI = 34 * MiB, WS_WFO = 78 * MiB;
constexpr size_t WS_XN = 100 * MiB, WS_MIX = 136 * MiB, WS_YS5 = 172 * MiB;
constexpr size_t WS_U = 190 * MiB, WS_Q = 208 * MiB, WS_K = 226 * MiB, WS_V = 244 * MiB, WS_G = 262 * MiB, WS_O = 280 * MiB;
constexpr size_t WS_ACT = 190 * MiB;
constexpr size_t WS_SLAB4 = 190 * MiB;
constexpr size_t WS_SLAB7 = 4 * MiB;
constexpr size_t WS_S5L = 298 * MiB, WS_S5H = 306 * MiB, WS_S5G = 310 * MiB;
constexpr size_t WS_END = 314 * MiB;
constexpr int CW_BAR = 4096;
constexpr size_t WS_SS = 32 * 1024;
constexpr int LDS_BYTES = 147456, LDSCTL_OFF = 139264, MISC_OFF = LDSCTL_OFF + 320;
#ifndef PG8_SP2
#define PG8_SP2 true
#endif
#ifndef PG8_ALIGN
#define PG8_ALIGN true
#endif
namespace pg8 {
#define PG8_LAS __attribute__((address_space(3)))
typedef unsigned short bf16_t;
typedef short bf16x8 __attribute__((ext_vector_type(8)));
typedef float f32x4 __attribute__((ext_vector_type(4)));
typedef unsigned u32x4 __attribute__((ext_vector_type(4)));
constexpr int BM = 256, BK = 64, HALF = 128, HTB = HALF * BK * 2  , STAGE_BYTES = 8 * HTB, NXCD = 8, WGM = 8;

__host__ __device__ __forceinline__ int lds_byte(int r, int c) { const int st = (r >> 4) * 2 + (c >> 5), rr = r & 15, cc = c & 31, ob = rr * 64 + cc * 2; return st * 1024 + (ob ^ (((ob >> 9) & 1) << 5)); }
__host__ __device__ __forceinline__ void stage_rc(int b, int& R, int& C) { const int st = b / 1024, sb = b % 1024, swz = sb ^ (((sb >> 9) & 1) << 5); R = (st >> 1) * 16 + swz / 64; C = (st & 1) * 32 + (swz % 64) / 2; }
__host__ __device__ __forceinline__ int perm32(int rho) { const int n = rho >> 4, i = rho & 15; return 8 * (i >> 2) + 4 * n + (i & 3); }

struct Unit { int pm, pn, kt0, nt, sp, hm, roff; };
struct Gemm { const bf16_t* A; const bf16_t* Bt; int M, N, K; };

struct StaticOrder {
    int nM, nN, nwg, G, c, ntk;
    __host__ __device__ __forceinline__ void init(int M, int N, int K, int G_, int c_) { nM = M / BM; nN = N / BM; nwg = nM * nN; G = G_; c = c_; ntk = K / BK; }
    __host__ __device__ __forceinline__ bool next(int i, Unit& u) const { return map((long)i * G + c, u); }
    __host__ __device__ __forceinline__ bool map(const long L, Unit& u) const {
        if (L >= nwg) return false;
        u.kt0 = 0; u.nt = ntk; u.sp = -1; u.hm = 0; u.roff = 0;
        int wgid = (int)L; { const int q = nwg / NXCD, r = nwg % NXCD, xcd = wgid % NXCD, off = wgid / NXCD; wgid = (xcd < r ? xcd * (q + 1) : r * (q + 1) + (xcd - r) * q) + off; }
        const int nig = WGM * nN, gid = wgid / nig, fm = gid * WGM, gsz = (nM - fm) < WGM ? (nM - fm) : WGM;
        u.pm = fm + ((wgid % nig) % gsz); u.pn = (wgid % nig) / gsz; return true;
    }
    __device__ __forceinline__ void a_ready(const Unit&) const {}
    __device__ __forceinline__ void done(const Unit&) const {}
};

struct HalfTailOrder {
    StaticOrder so; int R, T;
    __host__ __device__ __forceinline__ void init(int M, int N, int K, int G_, int c_) { so.init(M, N, K, G_, c_); R = so.nwg / G_; T = so.nwg - R * G_; }
    __host__ __device__ __forceinline__ bool next(int i, Unit& u) const {
        const bool halves = (i == R) && (2 * T <= so.G);
        if (i > R || (halves && so.c >= 2 * T)) return false;
        const long L = halves ? (long)R * so.G + (so.c >> 1) : (long)i * so.G + so.c;
        const bool ok = so.map(L, u);
        u.hm = halves ? 1 : 0; u.roff = halves ? 128 * (so.c & 1) : 0;
        return ok;
    }
    __device__ __forceinline__ void a_ready(const Unit&) const {}
    __device__ __forceinline__ void done(const Unit&) const {}
};

struct SplitOrder {
    StaticOrder so; int c, ntk;
    __host__ __device__ __forceinline__ void init(int K, int G_, int c_) { so.init(8192, 2048, K, G_, c_); c = c_; ntk = K / BK; }
    __host__ __device__ __forceinline__ bool next(int i, Unit& u) const {
        if (i == 0) return so.next(0, u);
        if (i > 1) return false;
        const int s = c & 7, ui = c >> 3;
        u.pm = 32 + (ui >> 3); u.pn = ui & 7; u.sp = s; u.hm = 0; u.roff = 0;
        if (ntk == 32) { u.kt0 = 4 * s; u.nt = 4; }
        else { u.kt0 = 22 * (s >> 1) + 12 * (s & 1); u.nt = (s & 1) ? 10 : 12; }
        return true;
    }
    __device__ __forceinline__ void a_ready(const Unit&) const {}
    __device__ __forceinline__ void done(const Unit&) const {}
};

typedef float cvf32x2_t __attribute__((ext_vector_type(2))); typedef __bf16 cvbf16x2_t __attribute__((ext_vector_type(2)));
__device__ __forceinline__ unsigned cvt_pk_bf16(float lo, float hi) { const cvf32x2_t v = {lo, hi}; const cvbf16x2_t b = __builtin_convertvector(v, cvbf16x2_t); return __builtin_bit_cast(unsigned, b); }
typedef unsigned u32x2 __attribute__((ext_vector_type(2)));
__device__ __forceinline__ float bf_lo(unsigned w) { return __uint_as_float(w << 16); }
__device__ __forceinline__ float bf_hi(unsigned w) { return __uint_as_float(w & 0xffff0000u); }
__device__ __forceinline__ float fsigmoid(float x) { return __builtin_amdgcn_rcpf(1.f + __expf(-x)); }
__device__ __forceinline__ u32x4 pack8(const f32x4 a, const f32x4 b) { u32x4 w; w.x = cvt_pk_bf16(a[0], a[1]); w.y = cvt_pk_bf16(a[2], a[3]); w.z = cvt_pk_bf16(b[0], b[1]); w.w = cvt_pk_bf16(b[2], b[3]); return w; }

struct EpiProj {
    static constexpr bool PERM = true, AFTER_DRAIN = false;
    __device__ __forceinline__ void init(f32x4 (&acc)[2][2][4][2], const Unit&, int, int, int, int) const {
#pragma unroll
        for (int a = 0; a < 2; ++a)
#pragma unroll
            for (int b = 0; b < 2; ++b)
#pragma unroll
                for (int m = 0; m < 4; ++m)
#pragma unroll
                    for (int n = 0; n < 2; ++n) acc[a][b][m][n] = (f32x4){0.f, 0.f, 0.f, 0.f};
    }
    bf16_t* base5;
    static constexpr size_t KSTRIDE = (size_t)18 * 1024 * 1024 / 2;
    const float *ropec, *ropes;
    const float* ss0;
    __device__ __forceinline__ void operator()(const f32x4 (&acc)[2][2][4][2], const Unit& u, int wr, int wc, int fr, int fq) const {
        const int kind = u.pn >> 2, sub = u.pn & 3;
        const int row0 = u.pm * BM + wr * 64 + fr;
        float srv[2][4];
#pragma unroll
        for (int ai = 0; ai < 2; ++ai)
#pragma unroll
            for (int m = 0; m < 4; ++m) srv[ai][m] = ss0[row0 + ai * HALF + m * 16];
        if (kind == 1 || kind == 2) {
            bf16_t* dst = base5 + (size_t)kind * KSTRIDE;
            const int head = 2 * sub + (wc >> 1), j0 = 32 * (wc & 1) + 8 * fq;
            const float l2g = __log2f(1.f - exp2f(-5.f - (float)head));
            const float ksc = (kind == 2) ? 0.08838834764831845f : 1.f;
#pragma unroll
            for (int ai = 0; ai < 2; ++ai)
#pragma unroll
                for (int m = 0; m < 4; ++m) {
                    const int r = row0 + ai * HALF + m * 16;
                    int pi; float sc;
                    if (r < 8192) { const int t = r & 2047; pi = t; const int tt = t & 127; sc = exp2f(l2g * (kind == 1 ? (float)(tt - 127) : (float)(127 - tt))) * ksc; }
                    else { pi = 2048 + (r & 7); sc = ksc; }
                    const f32x4 c0 = *(const f32x4*)(ropec + pi * 64 + j0), c1 = *(const f32x4*)(ropec + pi * 64 + j0 + 4);
                    const f32x4 s0 = *(const f32x4*)(ropes + pi * 64 + j0), s1 = *(const f32x4*)(ropes + pi * 64 + j0 + 4);
                    sc *= rsqrtf(srv[ai][m] * (1.f / 2048.f) + 1e-6f);
                    const f32x4 x1a = acc[ai][0][m][0], x1b = acc[ai][0][m][1], x2a = acc[ai][1][m][0], x2b = acc[ai][1][m][1];
                    const f32x4 r1a = (x1a * c0 - x2a * s0) * sc, r1b = (x1b * c1 - x2b * s1) * sc;
                    const f32x4 r2a = (x1a * s0 + x2a * c0) * sc, r2b = (x1b * s1 + x2b * c1) * sc;
                    bf16_t* rowp = dst + (size_t)r * 1024 + head * 128 + j0;
                    *(u32x4*)(rowp) = pack8(r1a, r1b);
                    *(u32x4*)(rowp + 64) = pack8(r2a, r2b);
                }
        } else {
            bf16_t* dst = base5 + (size_t)kind * KSTRIDE;
            const int col0 = 256 * sub + wc * 32 + 8 * fq;
#pragma unroll
            for (int ai = 0; ai < 2; ++ai)
#pragma unroll
                for (int m = 0; m < 4; ++m) {
                    bf16_t* rowp = dst + (size_t)(row0 + ai * HALF + m * 16) * 1024 + col0;
                    const float sr = rsqrtf(srv[ai][m] * (1.f / 2048.f) + 1e-6f);
#pragma unroll
                    for (int bj = 0; bj < 2; ++bj) {
                        f32x4 v0 = acc[ai][bj][m][0] * sr, v1 = acc[ai][bj][m][1] * sr;
                        if (kind == 4) {
#pragma unroll
                            for (int i = 0; i < 4; ++i) { v0[i] = v0[i] * fsigmoid(v0[i]); v1[i] = v1[i] * fsigmoid(v1[i]); }
                        }
                        *(u32x4*)(rowp + bj * HALF) = pack8(v0, v1);
                    }
                }
        }
    }
};

struct EpiGlu {
    static constexpr bool PERM = true, AFTER_DRAIN = false;
    __device__ __forceinline__ void init(f32x4 (&acc)[2][2][4][2], const Unit&, int, int, int, int) const {
#pragma unroll
        for (int a = 0; a < 2; ++a)
#pragma unroll
            for (int b = 0; b < 2; ++b)
#pragma unroll
                for (int m = 0; m < 4; ++m)
#pragma unroll
                    for (int n = 0; n < 2; ++n) acc[a][b][m][n] = (f32x4){0.f, 0.f, 0.f, 0.f};
    }
    const bf16_t* Y; bf16_t* O; const float* bias;
    __device__ __forceinline__ void operator()(const f32x4 (&acc)[2][2][4][2], const Unit& u, int wr, int wc, int fr, int fq) const {
        const int row0 = u.pm * BM + wr * 64 + fr, col0 = u.pn * BM + wc * 32 + 8 * fq;
        f32x4 bv[2][2];
#pragma unroll
        for (int bj = 0; bj < 2; ++bj)
#pragma unroll
            for (int n = 0; n < 2; ++n) bv[bj][n] = *(const f32x4*)(bias + col0 + bj * HALF + 4 * n);
#pragma unroll
        for (int ai = 0; ai < 2; ++ai)
#pragma unroll
            for (int m = 0; m < 4; ++m) {
                const size_t r = (size_t)(row0 + ai * HALF + m * 16);
#pragma unroll
                for (int bj = 0; bj < 2; ++bj) {
                    const u32x4 yw = *(const u32x4*)(Y + r * 1024 + col0 + bj * HALF);
                    const f32x4 z0 = acc[ai][bj][m][0] + bv[bj][0], z1 = acc[ai][bj][m][1] + bv[bj][1];
                    f32x4 o0, o1;
                    o0[0] = bf_lo(yw.x) * fsigmoid(z0[0]); o0[1] = bf_hi(yw.x) * fsigmoid(z0[1]); o0[2] = bf_lo(yw.y) * fsigmoid(z0[2]); o0[3] = bf_hi(yw.y) * fsigmoid(z0[3]);
                    o1[0] = bf_lo(yw.z) * fsigmoid(z1[0]); o1[1] = bf_hi(yw.z) * fsigmoid(z1[1]); o1[2] = bf_lo(yw.w) * fsigmoid(z1[2]); o1[3] = bf_hi(yw.w) * fsigmoid(z1[3]);
                    *(u32x4*)(O + r * 2048 + col0 + bj * HALF) = pack8(o0, o1);
                }
            }
    }
};

struct EpiSwiglu {
    static constexpr bool PERM = true, AFTER_DRAIN = false;
    __device__ __forceinline__ void init(f32x4 (&acc)[2][2][4][2], const Unit&, int, int, int, int) const {
#pragma unroll
        for (int a = 0; a < 2; ++a)
#pragma unroll
            for (int b = 0; b < 2; ++b)
#pragma unroll
                for (int m = 0; m < 4; ++m)
#pragma unroll
                    for (int n = 0; n < 2; ++n) acc[a][b][m][n] = (f32x4){0.f, 0.f, 0.f, 0.f};
    }
    bf16_t* O; int ldo; const float* ss;
    __device__ __forceinline__ void operator()(const f32x4 (&acc)[2][2][4][2], const Unit& u, int wr, int wc, int fr, int fq) const {
        const int row0 = u.pm * BM + u.roff + wr * 64 + fr, col0 = u.pn * HALF + wc * 32 + 8 * fq;
        float srv[2][4];
#pragma unroll
        for (int ai = 0; ai < 2; ++ai)
#pragma unroll
            for (int m = 0; m < 4; ++m) srv[ai][m] = (ai == 1 && u.hm) ? 1.f : ss[row0 + ai * HALF + m * 16];
#pragma unroll
        for (int ai = 0; ai < 2; ++ai)
#pragma unroll
            for (int m = 0; m < 4; ++m) {
                if (ai == 1 && u.hm) continue;
                const float sr = rsqrtf(srv[ai][m] * (1.f / 2048.f) + 1e-6f);
                const f32x4 g0 = acc[ai][0][m][0] * sr, g1 = acc[ai][0][m][1] * sr, u0 = acc[ai][1][m][0] * sr, u1 = acc[ai][1][m][1] * sr;
                f32x4 a0, a1;
#pragma unroll
                for (int i = 0; i < 4; ++i) { a0[i] = g0[i] * fsigmoid(g0[i]) * u0[i]; a1[i] = g1[i] * fsigmoid(g1[i]) * u1[i]; }
                *(u32x4*)(O + (size_t)(row0 + ai * HALF + m * 16) * ldo + col0) = pack8(a0, a1);
            }
    }
};

template <int MODE> struct EpiResid {
    static constexpr bool PERM = true, AFTER_DRAIN = false;
    bf16_t* xb; bf16_t* slab; float* ss;
    __device__ __forceinline__ void init(f32x4 (&acc)[2][2][4][2], const Unit& u, int wr, int wc, int fr, int fq) const {
        const int row0 = u.pm * BM + wr * 64 + fr, col0 = u.pn * BM + wc * 32 + 8 * fq;
#pragma unroll
        for (int ai = 0; ai < 2; ++ai)
#pragma unroll
            for (int m = 0; m < 4; ++m) {
                const bf16_t* xr = xb + (size_t)(row0 + ai * HALF + m * 16) * 2048 + col0;
#pragma unroll
                for (int bj = 0; bj < 2; ++bj) {
                    if (u.sp >= 0) { acc[ai][bj][m][0] = (f32x4){0.f, 0.f, 0.f, 0.f}; acc[ai][bj][m][1] = (f32x4){0.f, 0.f, 0.f, 0.f}; }
                    else { const u32x4 w = *(const u32x4*)(xr + bj * HALF);
                        acc[ai][bj][m][0] = (f32x4){bf_lo(w.x), bf_hi(w.x), bf_lo(w.y), bf_hi(w.y)}; acc[ai][bj][m][1] = (f32x4){bf_lo(w.z), bf_hi(w.z), bf_lo(w.w), bf_hi(w.w)}; }
                }
            }
    }
    __device__ __forceinline__ void operator()(const f32x4 (&acc)[2][2][4][2], const Unit& u, int wr, int wc, int fr, int fq) const {
        const int row0 = u.pm * BM + wr * 64 + fr, col0 = u.pn * BM + wc * 32 + 8 * fq;
        if (u.sp >= 0) {
            bf16_t* sb = slab + ((size_t)u.sp * 1024 + (size_t)(row0 - 8192)) * 2048 + col0;
#pragma unroll
            for (int ai = 0; ai < 2; ++ai)
#pragma unroll
                for (int m = 0; m < 4; ++m)
#pragma unroll
                    for (int bj = 0; bj < 2; ++bj) *(u32x4*)(sb + (size_t)(ai * HALF + m * 16) * 2048 + bj * HALF) = pack8(acc[ai][bj][m][0], acc[ai][bj][m][1]);
            return;
        }
#pragma unroll
        for (int ai = 0; ai < 2; ++ai)
#pragma unroll
            for (int m = 0; m < 4; ++m) {
                const int r = row0 + ai * HALF + m * 16;
                bf16_t* xr = xb + (size_t)r * 2048 + col0;
                float q = 0.f;
#pragma unroll
                for (int bj = 0; bj < 2; ++bj) { const f32x4 v0 = acc[ai][bj][m][0], v1 = acc[ai][bj][m][1];
                    q += ((v0[0] * v0[0] + v0[1] * v0[1]) + (v0[2] * v0[2] + v0[3] * v0[3])) + ((v1[0] * v1[0] + v1[1] * v1[1]) + (v1[2] * v1[2] + v1[3] * v1[3]));
                    *(u32x4*)(xr + bj * HALF) = pack8(v0, v1); }
                if (MODE == 0) { q += __shfl_xor(q, 16); q += __shfl_xor(q, 32); if (fq == 0) atomicAdd(ss + r, q); }
            }
    }
};

template <class Epi, class Sched, bool ALIGN_EPI = false, bool SP2 = false>
__device__ __forceinline__ void gemm_phase(PG8_LAS unsigned char* lds, const Gemm g, const Sched& S, const Epi& E) {
    const int tid = threadIdx.x, wid = __builtin_amdgcn_readfirstlane(tid >> 6), lane = tid & 63, wr = wid >> 2, wc = wid & 3, fr = lane & 15, fq = lane >> 4;
    const int K = g.K;
    unsigned voffA[2], voffB[2];
#pragma unroll
    for (int i = 0; i < 2; ++i) { int R, C; stage_rc(tid * 16 + i * 8192, R, C); const int Rb = Epi::PERM ? ((R & ~31) + perm32(R & 31)) : R;
        voffA[i] = (unsigned)(R * K + C) * 2u; voffB[i] = (unsigned)(Rb * K + C) * 2u; }
    const size_t kstep = (size_t)(BK * 2);
    const size_t hstep = (size_t)HALF * K * 2;
    const size_t tstep = 2 * hstep;
    const unsigned ldsw = (unsigned)wid * 1024u;
    const int aoff = lds_byte(wr * 64 + fr, fq * 8), boff = lds_byte(wc * 32 + fr, fq * 8);
#define PG8_SA(b, h) (((b) * 2 + (h)) * HTB)
#define PG8_SB(b, h) ((4 + (b) * 2 + (h)) * HTB)
#define PG8_STAGE(bufoff, gbase, voff) do { _Pragma("unroll") for (int _i = 0; _i < 2; ++_i) \
        __builtin_amdgcn_global_load_lds((const unsigned*)((const char*)(gbase) + (voff)[_i]), (PG8_LAS unsigned*)(lds + (bufoff) + ldsw + _i * 8192), 16, 0, 0); } while (0)
#define PG8_LDA(dst, b, h) do { _Pragma("unroll") for (int m = 0; m < 4; ++m) _Pragma("unroll") for (int k = 0; k < 2; ++k) dst[m][k] = *(const PG8_LAS bf16x8*)(lds + PG8_SA(b, h) + aoff + m * 2048 + k * 1024); } while (0)
#define PG8_LDB(dst, b, h) do { _Pragma("unroll") for (int n = 0; n < 2; ++n) _Pragma("unroll") for (int k = 0; k < 2; ++k) dst[n][k] = *(const PG8_LAS bf16x8*)(lds + PG8_SB(b, h) + boff + n * 2048 + k * 1024); } while (0)
#define PG8_MMA(ai, bj, At, Bt) do { __builtin_amdgcn_s_setprio(1); _Pragma("unroll") for (int m = 0; m < 4; ++m) _Pragma("unroll") for (int n = 0; n < 2; ++n) _Pragma("unroll") for (int k = 0; k < 2; ++k) \
        acc[ai][bj][m][n] = __builtin_amdgcn_mfma_f32_16x16x32_bf16(Bt[n][k], At[m][k], acc[ai][bj][m][n], 0, 0, 0); __builtin_amdgcn_s_setprio(0); } while (0)
#define PG8_WAIT_V(n) asm volatile("s_waitcnt vmcnt(" #n ")" ::: "memory")
#define PG8_WAIT_L(n) asm volatile("s_waitcnt lgkmcnt(" #n ")" ::: "memory")
#define PG8_BAR __builtin_amdgcn_s_barrier()
#define PG8_SCHED __builtin_amdgcn_sched_barrier(0)
    Unit cur, nxt; int ui = 0;
    if (!S.next(0, cur)) return;
    f32x4 acc[2][2][4][2];
    E.init(acc, cur, wr, wc, fr, fq);
    bf16x8 At[4][2], B0[2][2], B1[2][2];
    const char* cA = (const char*)g.A + (size_t)cur.pm * tstep + (size_t)cur.kt0 * kstep + (size_t)cur.roff * K * 2; const char* cB = (const char*)g.Bt + (size_t)cur.pn * tstep + (size_t)cur.kt0 * kstep;
    S.a_ready(cur);
    if constexpr (SP2) {
        PG8_STAGE(PG8_SB(0, 0), cB, voffB); PG8_STAGE(PG8_SB(0, 1), cB + hstep, voffB); PG8_STAGE(PG8_SA(0, 0), cA, voffA); PG8_STAGE(PG8_SA(0, 1), cA + hstep, voffA);
        if (wr == 1) PG8_BAR;
        PG8_WAIT_V(2); PG8_BAR;
        PG8_STAGE(PG8_SB(1, 0), cB + kstep, voffB); PG8_STAGE(PG8_SA(1, 0), cA + kstep, voffA); PG8_STAGE(PG8_SB(1, 1), cB + hstep + kstep, voffB);
        PG8_WAIT_V(6); PG8_BAR;
    } else {
        PG8_STAGE(PG8_SB(0, 0), cB, voffB); PG8_STAGE(PG8_SA(0, 0), cA, voffA); PG8_STAGE(PG8_SB(0, 1), cB + hstep, voffB); PG8_STAGE(PG8_SA(0, 1), cA + hstep, voffA);
        if (wr == 1) PG8_BAR;
        PG8_WAIT_V(4); PG8_BAR;
        PG8_STAGE(PG8_SB(1, 0), cB + kstep, voffB); PG8_STAGE(PG8_SA(1, 0), cA + kstep, voffA); PG8_STAGE(PG8_SB(1, 1), cB + hstep + kstep, voffB);
        PG8_WAIT_V(6); PG8_BAR;
    }
    for (;;) {
        const bool has_next = S.next(ui + 1, nxt);
        const char* nA = has_next ? (const char*)g.A + (size_t)nxt.pm * tstep + (size_t)nxt.kt0 * kstep + (size_t)nxt.roff * K * 2 : cA; const char* nB = has_next ? (const char*)g.Bt + (size_t)nxt.pn * tstep + (size_t)nxt.kt0 * kstep : cB;
        const int nt = cur.nt; const bool full = (cur.hm == 0);
        for (int t = 0; t < nt; t += 2) {
            const bool last = (t == nt - 2);
            const char* a1 = cA + (size_t)(t + 1) * kstep;
            const char* a2 = last ? nA : cA + (size_t)(t + 2) * kstep; const char* b2 = last ? nB : cB + (size_t)(t + 2) * kstep;
            const char* a3 = a2 + kstep; const char* b3 = b2 + kstep;
            if (last && has_next) S.a_ready(nxt);
            if constexpr (SP2) {
            PG8_LDB(B0, 0, 0); PG8_LDB(B1, 0, 1); PG8_SCHED; PG8_LDA(At, 0, 0); PG8_STAGE(PG8_SA(1, 1), a1 + hstep, voffA);
            PG8_WAIT_V(8); PG8_WAIT_L(0); PG8_BAR; PG8_MMA(0, 0, At, B0); PG8_MMA(0, 1, At, B1); PG8_BAR; PG8_SCHED;
            if (full) PG8_LDA(At, 0, 1); PG8_STAGE(PG8_SB(0, 0), b2, voffB); PG8_STAGE(PG8_SB(0, 1), b2 + hstep, voffB); PG8_STAGE(PG8_SA(0, 0), a2, voffA);
            PG8_WAIT_V(8); PG8_WAIT_L(0); PG8_BAR; if (full) { PG8_MMA(1, 0, At, B0); PG8_MMA(1, 1, At, B1); } PG8_BAR; PG8_SCHED;
            PG8_LDB(B0, 1, 0); PG8_LDB(B1, 1, 1); PG8_SCHED; PG8_LDA(At, 1, 0); PG8_STAGE(PG8_SA(0, 1), a2 + hstep, voffA);
            PG8_WAIT_V(8); PG8_WAIT_L(0); PG8_BAR; PG8_MMA(0, 0, At, B0); PG8_MMA(0, 1, At, B1); PG8_BAR; PG8_SCHED;
            if (full) PG8_LDA(At, 1, 1); PG8_STAGE(PG8_SB(1, 0), b3, voffB); PG8_STAGE(PG8_SB(1, 1), b3 + hstep, voffB); PG8_STAGE(PG8_SA(1, 0), a3, voffA);
            PG8_WAIT_V(8); PG8_WAIT_L(0); PG8_BAR; if (full) { PG8_MMA(1, 0, At, B0); PG8_MMA(1, 1, At, B1); } PG8_BAR; PG8_SCHED;
            } else {
            PG8_LDB(B0, 0, 0); PG8_SCHED; PG8_LDA(At, 0, 0); PG8_STAGE(PG8_SA(1, 1), a1 + hstep, voffA);
            PG8_WAIT_L(8); PG8_BAR; PG8_WAIT_L(0); PG8_MMA(0, 0, At, B0); PG8_BAR; PG8_SCHED;
            PG8_LDB(B1, 0, 1); PG8_STAGE(PG8_SB(0, 0), b2, voffB);
            PG8_BAR; PG8_WAIT_L(0); PG8_MMA(0, 1, At, B1); PG8_BAR;
            PG8_LDA(At, 0, 1); PG8_STAGE(PG8_SA(0, 0), a2, voffA);
            PG8_BAR; PG8_WAIT_L(0); PG8_MMA(1, 0, At, B0); PG8_BAR; PG8_SCHED;
            PG8_STAGE(PG8_SB(0, 1), b2 + hstep, voffB);
            PG8_WAIT_V(6); PG8_BAR; PG8_MMA(1, 1, At, B1); PG8_BAR;
            PG8_LDB(B0, 1, 0); PG8_SCHED; PG8_LDA(At, 1, 0); PG8_STAGE(PG8_SA(0, 1), a2 + hstep, voffA);
            PG8_WAIT_L(8); PG8_BAR; PG8_WAIT_L(0); PG8_MMA(0, 0, At, B0); PG8_BAR; PG8_SCHED;
            PG8_LDB(B1, 1, 1); PG8_STAGE(PG8_SB(1, 0), b3, voffB);
            PG8_BAR; PG8_WAIT_L(0); PG8_MMA(0, 1, At, B1); PG8_BAR;
            PG8_LDA(At, 1, 1); PG8_STAGE(PG8_SA(1, 0), a3, voffA);
            PG8_BAR; PG8_WAIT_L(0); PG8_MMA(1, 0, At, B0); PG8_BAR; PG8_SCHED;
            PG8_STAGE(PG8_SB(1, 1), b3 + hstep, voffB);
            PG8_WAIT_V(6); PG8_BAR; PG8_MMA(1, 1, At, B1); PG8_BAR;
            }
        }
        if constexpr (ALIGN_EPI) { if (wr == 0) PG8_BAR; }
        if constexpr (!Epi::AFTER_DRAIN) { E(acc, cur, wr, wc, fr, fq); S.done(cur); }
        if (!has_next) break;
        E.init(acc, nxt, wr, wc, fr, fq);
        cur = nxt; cA = nA; cB = nB; ++ui;
        if constexpr (ALIGN_EPI) { if (wr == 1) PG8_BAR; }
    }
    PG8_WAIT_V(0);
    if constexpr (!ALIGN_EPI) { if (wr == 0) PG8_BAR; }
    PG8_BAR;
    if constexpr (Epi::AFTER_DRAIN) { E.fused(acc, cur, wr, wc, fr, fq, lds, wid, lane); S.done(cur); }
#undef PG8_SA
#undef PG8_SB
#undef PG8_STAGE
#undef PG8_LDA
#undef PG8_LDB
#undef PG8_MMA
#undef PG8_WAIT_V
#undef PG8_WAIT_L
#undef PG8_BAR
#undef PG8_SCHED
}
}
#define GAS __attribute__((address_space(1)))
#define LAS __attribute__((address_space(3)))
typedef unsigned short bf16;
typedef unsigned v4u __attribute__((ext_vector_type(4)));
typedef float f32x4 __attribute__((ext_vector_type(4)));
typedef short bf16x8 __attribute__((ext_vector_type(8)));
typedef GAS unsigned gu32;
typedef GAS unsigned long long gu64;
#define RLX_AGENT __ATOMIC_RELAXED, __HIP_MEMORY_SCOPE_AGENT
#define LDS_WAIT() asm volatile("s_waitcnt lgkmcnt(0)" ::: "memory")
#define VM_WAIT() asm volatile("s_waitcnt vmcnt(0)" ::: "memory")
__device__ __forceinline__ unsigned long long rt() { return __builtin_amdgcn_s_memrealtime(); }
__device__ __forceinline__ unsigned f2bf(float f) { unsigned u = __builtin_bit_cast(unsigned, f); return (u + 0x7fffu + ((u >> 16) & 1u)) >> 16; }
__device__ __forceinline__ unsigned pk2(float lo, float hi) { return f2bf(lo) | (f2bf(hi) << 16); }

#define XB_TMO      128
#define XB_XCNT(j)  (256  + 64 * (j))
#define XB_XSUB(j)  (1280 + 64 * (j))
#define XB_XGEN(j)  (2304 + 64 * (j))
#define XB_TOP      3328
#define XB_TOPGEN   3392
#define XCD_BAR_WORDS 3456
#define XB_SPIN_CAP (1u << 18)

__device__ __forceinline__ unsigned xb_ld(unsigned* p)              { return __hip_atomic_load(p, __ATOMIC_RELAXED, __HIP_MEMORY_SCOPE_AGENT); }
__device__ __forceinline__ unsigned xb_add(unsigned* p, unsigned v) { return __hip_atomic_fetch_add(p, v, __ATOMIC_RELAXED, __HIP_MEMORY_SCOPE_AGENT); }
__device__ __forceinline__ unsigned xb_xcc_id() { return (unsigned)__builtin_amdgcn_s_getreg((3 << 11) | 20) & 0xFu; }
#define XB_SPIN(cond, bar) do { unsigned _sp = 0; while (cond) { __builtin_amdgcn_s_sleep(1); \
    if ((++_sp & 255u) == 0u) { if (xb_ld(&(bar)[XB_TMO])) break; if (_sp > XB_SPIN_CAP) { atomicAdd(&(bar)[XB_TMO], 1u); break; } } } } while (0)

struct XcdBarrier {
    unsigned* bar; unsigned x;
    volatile LAS unsigned* st;
};

__device__ __forceinline__ XcdBarrier xcd_barrier_post(unsigned* bar, volatile LAS unsigned* st) {
    XcdBarrier b; b.bar = bar; b.x = xb_xcc_id(); b.st = st;
    if (threadIdx.x == 0) (void)xb_add(&bar[XB_XCNT(b.x)], 1u);
    return b;
}
__device__ __forceinline__ void xcd_barrier_complete(unsigned* bar, unsigned x, unsigned& nloc, unsigned& nx) {
    const unsigned G = gridDim.x * gridDim.y * gridDim.z;
    unsigned sum, cnt, mine, sp = 0u;
    for (;;) {
        sum = 0u; cnt = 0u; mine = 0u;
#pragma unroll
        for (unsigned j = 0; j < 16; ++j) { const unsigned c = xb_ld(&bar[XB_XCNT(j)]); sum += c; cnt += (c > 0u) ? 1u : 0u; mine = (j == x) ? c : mine; }
        if (sum == G) break;
        __builtin_amdgcn_s_sleep(1);
        if ((++sp & 255u) == 0u) { if (xb_ld(&bar[XB_TMO])) break; if (sp > XB_SPIN_CAP) { atomicAdd(&bar[XB_TMO], 1u); break; } }
    }
    nloc = mine > 0u ? mine : 1u; nx = cnt > 0u ? cnt : 1u;
}

__device__ __forceinline__ void xcd_barrier(const XcdBarrier& b) {
    asm volatile("s_waitcnt vmcnt(0)" ::: "memory");
    __syncthreads();
    if (threadIdx.x == 0) {
        unsigned* bar = b.bar;
        __builtin_amdgcn_s_waitcnt(0);
        unsigned nloc = b.st[0], nx = b.st[1];
        if (nloc == 0u) { xcd_barrier_complete(bar, b.x, nloc, nx); b.st[0] = nloc; b.st[1] = nx; }
        const unsigned old = xb_add(&bar[XB_XSUB(b.x)], 1u);
        const unsigned gen = old / nloc;
        if (old + 1u == (gen + 1u) * nloc) {
            __builtin_amdgcn_fence(__ATOMIC_RELEASE, "agent");
            asm volatile("s_waitcnt vmcnt(0)" ::: "memory");
            const unsigned og = xb_add(&bar[XB_TOP], 1u);
            const unsigned tg = og / nx;
            if (og + 1u == (tg + 1u) * nx) xb_add(&bar[XB_TOPGEN], 1u);
            else XB_SPIN(xb_ld(&bar[XB_TOPGEN]) == tg, bar);
            __builtin_amdgcn_fence(__ATOMIC_ACQUIRE, "agent");
            xb_add(&bar[XB_XGEN(b.x)], 1u);
            asm volatile("s_waitcnt vmcnt(0)" ::: "memory");
        } else {
            XB_SPIN(xb_ld(&bar[XB_XGEN(b.x)]) == gen, bar);
            __builtin_amdgcn_fence(__ATOMIC_ACQUIRE, "agent");
            asm volatile("s_waitcnt vmcnt(0)" ::: "memory");
        }
    }
    __syncthreads();
}

typedef short s16x4 __attribute__((ext_vector_type(4)));
typedef float f32x2v __attribute__((ext_vector_type(2)));
typedef float f32x16 __attribute__((ext_vector_type(16)));
typedef unsigned u32x2v __attribute__((ext_vector_type(2)));

struct Frame {
    LAS unsigned char* lds;
    volatile LAS unsigned* MISC;
    gu32* ctl;
    int tid, lane, wave;
    int G;
    const float *x_prompt, *x_sample, *st_re, *st_im, *st_ret, *norm_mix, *w_in, *lam_re, *lam_im, *log_step, *b_re, *b_im, *c_re, *c_im, *s5_d, *w_glu, *b_glu, *gn_w, *w_out, *norm_ffn, *w_ffn_in, *w_ffn_out, *norm_final;
    float *Y, *o_s5re_p, *o_s5im_p, *o_ret_p, *o_s5re_s, *o_s5im_s, *o_ret_s;
    float *LBR, *LBI, *ROPEC, *ROPES, *SS0;
    bf16 *BB, *CMT;
    bf16 *WIN_T, *WGLU_T, *WOUT_T, *WFI_T, *WFO_T;
    bf16 *XN, *U, *Q, *Kb, *V, *Gt, *Ob, *YS5, *MIX, *ACT;
    bf16 *S5Lm, *S5Hm, *S5Gm;
};

__device__ __forceinline__ float wave_sum(float v) {
#pragma unroll
    for (int o = 1; o < 64; o <<= 1) v += __shfl_xor(v, o);
    return v;
}
__device__ __forceinline__ unsigned offb(unsigned row, unsigned ch) { return 256u * row + 16u * (ch ^ (((row & 3u) << 2) | ((row >> 2) & 3u))); }
typedef float cvf32x2 __attribute__((ext_vector_type(2))); typedef __bf16 cvbf16x2 __attribute__((ext_vector_type(2)));
__device__ __forceinline__ unsigned cvtpk(float lo, float hi) { const cvf32x2 v = {lo, hi}; const cvbf16x2 b = __builtin_convertvector(v, cvbf16x2); return __builtin_bit_cast(unsigned, b); }
__device__ __forceinline__ float bflo(unsigned w) { return __uint_as_float(w << 16); }
__device__ __forceinline__ float bfhi(unsigned w) { return __uint_as_float(w & 0xffff0000u); }
__device__ __forceinline__ bf16x8 tr_pair(LAS unsigned char* base, unsigned a0, unsigned a1) {
    const s16x4 lo = __builtin_amdgcn_ds_read_tr16_b64_v4i16((LAS s16x4*)(base + a0));
    const s16x4 hi = __builtin_amdgcn_ds_read_tr16_b64_v4i16((LAS s16x4*)(base + a1));
    return __builtin_shufflevector(lo, hi, 0, 1, 2, 3, 4, 5, 6, 7);
}

#define LDS_BARRIER() do { asm volatile("s_waitcnt lgkmcnt(0)" ::: "memory"); __builtin_amdgcn_s_barrier(); asm volatile("" ::: "memory"); } while (0)
template <int K, int N> __device__ __forceinline__ void p0_ld(const float* W, int kb, int nb, float (&r)[32], int lane, const float* kscale = nullptr) {
#pragma unroll
    for (int i = 0; i < 32; ++i) r[i] = __builtin_nontemporal_load(W + (size_t)(64 * kb + 2 * i + (lane >> 5)) * N + 32 * nb + (lane & 31));
    if (kscale) {
#pragma unroll
        for (int i = 0; i < 32; ++i) r[i] *= kscale[64 * kb + 2 * i + (lane >> 5)];
    }
}
template <int K> __device__ __forceinline__ void p0_st(bf16* WT, int kb, int drow0, const float (&r)[32], LAS float* scr, int lane) {
#pragma unroll
    for (int i = 0; i < 32; ++i) scr[(2 * i + (lane >> 5)) * 33 + (lane & 31)] = r[i];
    LDS_WAIT(); asm volatile("" ::: "memory");
    const int c = lane & 7;
#pragma unroll
    for (int j = 0; j < 4; ++j) { const int n = (lane >> 3) + 8 * j; const LAS float* s = scr + (8 * c) * 33 + n;
        v4u o; o.x = pk2(s[0 * 33], s[1 * 33]); o.y = pk2(s[2 * 33], s[3 * 33]); o.z = pk2(s[4 * 33], s[5 * 33]); o.w = pk2(s[6 * 33], s[7 * 33]);
        *(GAS v4u*)(WT + (size_t)(drow0 + n) * K + 64 * kb + 8 * c) = o; }
    LDS_WAIT(); asm volatile("" ::: "memory");
}
__device__ __forceinline__ int win_dest_row(int n0) {
    if (n0 < 1024 || n0 >= 3072) return n0;
    const int kind = n0 >> 10, rel = n0 & 1023, head = rel >> 7, bj = (rel >> 6) & 1, j = rel & 63;
    return 1024 * kind + 256 * (head >> 1) + 128 * bj + 64 * (head & 1) + j;
}
__device__ __forceinline__ int wfi_dest_row(int n0) {
    const int up = n0 >= 5632 ? 1 : 0, cc = n0 - up * 5632;
    return 256 * (cc >> 7) + 128 * up + (cc & 127);
}
__device__ __forceinline__ void rms_row_load(const float* xrow, f32x4 (&v)[8], int lane) {
    const GAS f32x4* xr = (const GAS f32x4*)xrow + lane;
#pragma unroll
    for (int j = 0; j < 8; ++j) v[j] = __builtin_nontemporal_load(xr + 64 * j);
}
__device__ __forceinline__ void rms_row_finish(const f32x4 (&v)[8], float* ssrow, bf16* orow, int lane) {
    float s = 0.f;
#pragma unroll
    for (int j = 0; j < 8; ++j) s += (v[j].x * v[j].x + v[j].y * v[j].y) + (v[j].z * v[j].z + v[j].w * v[j].w);
    s = wave_sum(s);
    if (lane == 0) *ssrow = s;
    GAS unsigned long long* o8 = (GAS unsigned long long*)orow + lane;
#pragma unroll
    for (int j = 0; j < 8; ++j) o8[64 * j] = (unsigned long long)pk2(v[j].x, v[j].y) | ((unsigned long long)pk2(v[j].z, v[j].w) << 32);
}
__device__ __forceinline__ const float* xrow_ptr(const Frame& F, int r) { return r < 8192 ? F.x_prompt + (size_t)r * 2048 : F.x_sample + (size_t)(r - 8192) * 2048; }

constexpr int I_IN = 32 * 160, I_GLU = 16 * 32, I_OUT = 32 * 64, I_FI = 32 * 352, I_FO = 88 * 64, NITEMS = I_IN + I_GLU + I_OUT + I_FI + I_FO;
constexpr int I_FO_P0 = 1792;
__device__ __forceinline__ void p0_item_load(const Frame& F, int it, float (&r)[32], int lane) {
    int q = it;
    if (q < I_IN)  { p0_ld<2048, 5120>(F.w_in, q / 160, q % 160, r, lane, F.norm_mix); return; } q -= I_IN;
    if (q < I_GLU) { p0_ld<1024, 1024>(F.w_glu, q / 32, q % 32, r, lane); return; } q -= I_GLU;
    if (q < I_OUT) { p0_ld<2048, 2048>(F.w_out, q / 64, q % 64, r, lane); return; } q -= I_OUT;
    if (q < I_FI)  { p0_ld<2048, 11264>(F.w_ffn_in, q / 352, q % 352, r, lane, F.norm_ffn); return; } q -= I_FI;
    p0_ld<5632, 2048>(F.w_ffn_out, q / 64, q % 64, r, lane);
}
__device__ __forceinline__ void p0_item_store(const Frame& F, int it, const float (&r)[32], LAS float* scr, int lane) {
    int q = it;
    if (q < I_IN)  { p0_st<2048>(F.WIN_T, q / 160, win_dest_row(32 * (q % 160)), r, scr, lane); return; } q -= I_IN;
    if (q < I_GLU) { p0_st<1024>(F.WGLU_T, q / 32, 32 * (q % 32), r, scr, lane); return; } q -= I_GLU;
    if (q < I_OUT) { p0_st<2048>(F.WOUT_T, q / 64, 32 * (q % 64), r, scr, lane); return; } q -= I_OUT;
    if (q < I_FI)  { p0_st<2048>(F.WFI_T, q / 352, wfi_dest_row(32 * (q % 352)), r, scr, lane); return; } q -= I_FI;
    p0_st<5632>(F.WFO_T, q / 64, 32 * (q % 64), r, scr, lane);
}
__device__ __forceinline__ void p0_convert_items(const Frame& F, int first, int last, int gw, int NGW, LAS float* scr) {
    float ra[32], rb[32];
    int it = first + gw;
    if (it < last) p0_item_load(F, it, ra, F.lane);
    for (; it < last; it += 2 * NGW) {
        const bool hb = it + NGW < last, ha = it + 2 * NGW < last;
        if (hb) p0_item_load(F, it + NGW, rb, F.lane);
        p0_item_store(F, it, ra, scr, F.lane);
        if (ha) p0_item_load(F, it + 2 * NGW, ra, F.lane);
        if (hb) p0_item_store(F, it + NGW, rb, scr, F.lane);
    }
}
__device__ __forceinline__ void s5_lambar(const Frame& F, int i  , float& cr, float& ci, double& fr, double& fi) {
    const float dt = (float)exp((double)F.log_step[i >> 6]);
    const float lr = F.lam_re[i], li = F.lam_im[i];
    const float are = __fmul_rn(lr, dt), aim = __fmul_rn(li, dt);
    const float er = (float)exp((double)are), cs = (float)cos((double)aim), sn = (float)sin((double)aim);
    cr = __fmul_rn(er, cs); ci = __fmul_rn(er, sn);
    const double nr = (double)cr - 1.0, ni = (double)ci, den = (double)lr * lr + (double)li * li;
    fr = (nr * lr + ni * li) / den; fi = (ni * lr - nr * li) / den;
}
__device__ __forceinline__ void s5_precompute(Frame& F, const int g) {
    LAS float* PW = (LAS float*)F.lds;
    LAS float* BBL = PW + 17 * 64 * 2;
    LAS float* KT = BBL + 64 * 16 * 2;
    LAS float* CL = KT + 4096;
    const int tid = F.tid, lane = F.lane, w = F.wave;
#pragma unroll
    for (int i = 0; i < 2; ++i) { const int q = tid + 512 * i; CL[2 * q] = F.c_re[g * 1024 + q]; CL[2 * q + 1] = F.c_im[g * 1024 + q]; }
    if (tid < 64) {
        const int p = tid; const float cr = F.LBR[g * 64 + p], ci = F.LBI[g * 64 + p];
        const double lr = F.lam_re[g * 64 + p], li = F.lam_im[g * 64 + p];
        const double nr = (double)cr - 1.0, ni = (double)ci, den = lr * lr + li * li;
        const double fr = (nr * lr + ni * li) / den, fi = (ni * lr - nr * li) / den;
        float ar = 1.f, ai = 0.f;
        for (int t = 0; t < 17; ++t) { PW[(t * 64 + p) * 2] = ar; PW[(t * 64 + p) * 2 + 1] = ai; const float nr2 = ar * cr - ai * ci, ni2 = ar * ci + ai * cr; ar = nr2; ai = ni2; }
        for (int h = 0; h < 16; ++h) { const double br = F.b_re[(g * 64 + p) * 16 + h], bi = F.b_im[(g * 64 + p) * 16 + h];
            BBL[(p * 16 + h) * 2] = (float)(fr * br - fi * bi); BBL[(p * 16 + h) * 2 + 1] = (float)(fr * bi + fi * br); }
    }
    __syncthreads();
    {
        float c_r[16], c_i[16], b_r[16], b_i[16];
#pragma unroll
        for (int ks = 0; ks < 16; ++ks) { const int p = 4 * ks + (lane >> 4);
            c_r[ks] = CL[(((lane & 15)) * 64 + p) * 2]; c_i[ks] = CL[(((lane & 15)) * 64 + p) * 2 + 1];
            b_r[ks] = BBL[(p * 16 + (lane & 15)) * 2]; b_i[ks] = BBL[(p * 16 + (lane & 15)) * 2 + 1]; }
#pragma unroll
        for (int tt = 0; tt < 2; ++tt) { const int tau = 2 * w + tt;
            f32x4 acc = {0.f, 0.f, 0.f, 0.f};
#pragma unroll
            for (int ks = 0; ks < 16; ++ks) { const int p = 4 * ks + (lane >> 4);
                const float wr_ = PW[(tau * 64 + p) * 2], wi_ = PW[(tau * 64 + p) * 2 + 1];
                const float cwr = c_r[ks] * wr_ - c_i[ks] * wi_, cwi = c_r[ks] * wi_ + c_i[ks] * wr_;
                acc = __builtin_amdgcn_mfma_f32_16x16x4f32(cwr, b_r[ks], acc, 0, 0, 0);
                acc = __builtin_amdgcn_mfma_f32_16x16x4f32(-cwi, b_i[ks], acc, 0, 0, 0); }
#pragma unroll
            for (int e = 0; e < 4; ++e) KT[(tau << 8) | ((4 * (lane >> 4) + e) << 4) | (lane & 15)] = acc[e];
        }
    }
    __syncthreads();
#pragma unroll 1
    for (int q = 0; q < 4; ++q) {
    {
        const int r = 64 * q + (tid >> 3), t = r >> 4, h = r & 15, cb = tid & 7;
        bf16* dst = F.S5Lm + ((size_t)g * 256 + r) * 256 + 32 * cb;
#pragma unroll
        for (int k = 0; k < 4; ++k) { float v[8];
#pragma unroll
            for (int e = 0; e < 8; ++e) { const int col = 8 * k + e, s_ = 2 * cb + (col >> 4), hp = col & 15;
                float x = (s_ <= t) ? KT[((t - s_) << 8) | (h << 4) | hp] : 0.f; if (s_ == t && hp == h) x += F.s5_d[16 * g + h]; v[e] = x; }
            v4u o; o.x = pk2(v[0], v[1]); o.y = pk2(v[2], v[3]); o.z = pk2(v[4], v[5]); o.w = pk2(v[6], v[7]);
            *(GAS v4u*)(dst + 8 * k) = o; }
    }
    {
        const int j = 32 * q + (tid >> 4), p = j >> 1, im = j & 1, s_ = tid & 15;
        const float wr_ = PW[((15 - s_) * 64 + p) * 2], wi_ = PW[((15 - s_) * 64 + p) * 2 + 1];
        bf16* dst = F.S5Hm + ((size_t)g * 128 + j) * 256 + 16 * s_;
#pragma unroll
        for (int k = 0; k < 2; ++k) { float v[8];
#pragma unroll
            for (int e = 0; e < 8; ++e) { const int hp = 8 * k + e; const float b_r = BBL[(p * 16 + hp) * 2], b_i = BBL[(p * 16 + hp) * 2 + 1];
                v[e] = im ? (wr_ * b_i + wi_ * b_r) : (wr_ * b_r - wi_ * b_i); }
            v4u o; o.x = pk2(v[0], v[1]); o.y = pk2(v[2], v[3]); o.z = pk2(v[4], v[5]); o.w = pk2(v[6], v[7]);
            *(GAS v4u*)(dst + 8 * k) = o; }
    }
    {
        const int r = 64 * q + (tid >> 3), t = r >> 4, h = r & 15, cb = tid & 7;
        bf16* dst = F.S5Gm + ((size_t)g * 256 + r) * 128 + 16 * cb;
#pragma unroll
        for (int k = 0; k < 2; ++k) { float v[8];
#pragma unroll
            for (int e = 0; e < 4; ++e) { const int p = 8 * cb + 4 * k + e;
                const float c_r = CL[(h * 64 + p) * 2], c_i = CL[(h * 64 + p) * 2 + 1];
                const float wr_ = PW[((t + 1) * 64 + p) * 2], wi_ = PW[((t + 1) * 64 + p) * 2 + 1];
                v[2 * e] = c_r * wr_ - c_i * wi_; v[2 * e + 1] = -(c_r * wi_ + c_i * wr_); }
            v4u o; o.x = pk2(v[0], v[1]); o.y = pk2(v[2], v[3]); o.z = pk2(v[4], v[5]); o.w = pk2(v[6], v[7]);
            *(GAS v4u*)(dst + 8 * k) = o; }
    }
    }
    __syncthreads();
}
__device__ __forceinline__ void p0_prologue(Frame& F) {
    LAS float* scr = (LAS float*)(F.lds + F.wave * 16384);
    const int gw = (int)blockIdx.x * NWAVES + F.wave, NGW = F.G * NWAVES;
    p0_convert_items(F, 0, NITEMS - I_FO + I_FO_P0, gw, NGW, scr);
    {
        f32x4 va[8], vb[8];
        int m = gw;
        if (m < MROWS) rms_row_load(xrow_ptr(F, m), va, F.lane);
        for (; m < MROWS; m += 2 * NGW) {
            const bool hb = m + NGW < MROWS, ha = m + 2 * NGW < MROWS;
            if (hb) rms_row_load(xrow_ptr(F, m + NGW), vb, F.lane);
            rms_row_finish(va, F.SS0 + m, F.XN + (size_t)m * 2048, F.lane);
            if (ha) rms_row_load(xrow_ptr(F, m + 2 * NGW), va, F.lane);
            if (hb) rms_row_finish(vb, F.SS0 + m + NGW, F.XN + (size_t)(m + NGW) * 2048, F.lane);
        }
    }
    const int gt = (int)blockIdx.x * (NWAVES * 64) + F.tid, NGT = F.G * NWAVES * 64;
    for (int i = gt; i < 4096; i += NGT) {
        const int g = i >> 6, p = i & 63;
        const float dt = (float)exp((double)F.log_step[g]);
        const float lr = F.lam_re[i], li = F.lam_im[i];
        const float are = __fmul_rn(lr, dt), aim = __fmul_rn(li, dt);
        const float er = (float)exp((double)are), cs = (float)cos((double)aim), sn = (float)sin((double)aim);
        const float cr = __fmul_rn(er, cs), ci = __fmul_rn(er, sn);
        F.LBR[i] = cr; F.LBI[i] = ci;
        const double nr = (double)cr - 1.0, ni = (double)ci, den = (double)lr * lr + (double)li * li;
        const double fr = (nr * lr + ni * li) / den, fi = (ni * lr - nr * li) / den;
        for (int h = 0; h < 16; ++h) {
            const double br = F.b_re[i * 16 + h], bi = F.b_im[i * 16 + h];
            F.BB[((size_t)g * 128 + 2 * p) * 16 + h] = (bf16)f2bf((float)(fr * br - fi * bi));
            F.BB[((size_t)g * 128 + 2 * p + 1) * 16 + h] = (bf16)f2bf((float)(fr * bi + fi * br));
            F.CMT[((size_t)g * 16 + h) * 128 + 2 * p] = (bf16)f2bf(F.c_re[(g * 16 + h) * 64 + p]);
            F.CMT[((size_t)g * 16 + h) * 128 + 2 * p + 1] = (bf16)f2bf(-F.c_im[(g * 16 + h) * 64 + p]);
        }
    }
    for (int i = gt; i < 2056 * 64; i += NGT) {
        const int pi = i >> 6, j = i & 63;
        const float pos = pi < 2048 ? (float)pi : 16384.f + (float)(pi - 2048);
        const float inv = (float)pow(10000.0, -(double)j / 64.0);
        const float ang = __fmul_rn(pos, inv);
        F.ROPEC[i] = (float)cos((double)ang); F.ROPES[i] = (float)sin((double)ang);
    }
}

constexpr int S5L_BU = 0, S5L_XS = 65536, S5L_EX = 98304;
__device__ __forceinline__ float gelu_tanh(float y) {
    const float c = 0.7978845608028654f * (y + 0.044715f * y * y * y);
    const float e = __expf(2.f * c);
    const float th = 1.f - 2.f * __builtin_amdgcn_rcpf(1.f + e);
    return 0.5f * y * (1.f + th);
}
template <int MODE>
__device__ __forceinline__ void s5_item(Frame& F, const int g, const int idx) {
    LAS unsigned char* lds = F.lds;
    const int lane = F.lane, w = F.wave, p = lane;
    const int rowbase = (MODE == 0) ? idx * 2048 : 8192 + idx * 128;
    const int nblk = (MODE == 0) ? 16 : 1;
    const float lr = F.LBR[g * 64 + p], li = F.LBI[g * 64 + p];
    const int tt = w >> 1, jt0 = 2 * (w & 1);
    bf16x8 bbf[2];
#pragma unroll
    for (int q = 0; q < 2; ++q) bbf[q] = *(const GAS bf16x8*)(F.BB + ((size_t)g * 128 + 32 * (jt0 + q) + (lane & 31)) * 16 + 8 * (lane >> 5));
    bf16x8 cf[4];
#pragma unroll
    for (int s = 0; s < 4; ++s) cf[s] = *(const GAS bf16x8*)(F.CMT + ((size_t)g * 16 + (lane & 15)) * 128 + 32 * s + 8 * (lane >> 4));
    const f32x4 dreg = *(const GAS f32x4*)(F.s5_d + 16 * g + 4 * (lane >> 4));
    float l16r = 1.f, l16i = 0.f;
    float pwr[16], pwi[16];
    if (MODE == 0) {
        float ar = lr, ai = li;
#pragma unroll
        for (int k = 0; k < 16; ++k) { pwr[k] = ar; pwi[k] = ai; const float nr = ar * lr - ai * li, ni = ar * li + ai * lr; ar = nr; ai = ni; }
        l16r = pwr[15]; l16i = pwi[15];
    }
    const int xlane = 16 * (p >> 2) + 4 * (p & 3);
    float Xr = 0.f, Xi = 0.f;
    bf16x8 uf = *(const GAS bf16x8*)(F.U + (size_t)(rowbase + 32 * tt + (lane & 31)) * 1024 + 16 * g + 8 * (lane >> 5));
    for (int blk = 0; blk < nblk; ++blk) {
        const int rb = rowbase + 128 * blk;
#pragma unroll
        for (int q = 0; q < 2; ++q) {
            f32x16 z;
#pragma unroll
            for (int e = 0; e < 16; ++e) z[e] = 0.f;
            const f32x16 d = __builtin_amdgcn_mfma_f32_32x32x16_bf16(uf, bbf[q], z, 0, 0, 0);
            const int j = 32 * (jt0 + q) + (lane & 31);
#pragma unroll
            for (int e = 0; e < 16; ++e) { const int t = 32 * tt + (e & 3) + 8 * (e >> 2) + 4 * (lane >> 5);
                *(LAS float*)(lds + S5L_BU + (t * 128 + j) * 4) = d[e]; }
        }
        if (blk + 1 < nblk) uf = *(const GAS bf16x8*)(F.U + (size_t)(rb + 128 + 32 * tt + (lane & 31)) * 1024 + 16 * g + 8 * (lane >> 5));
        const size_t r = (size_t)(rb + 16 * w + (lane & 15));
        const int h0 = 16 * g + 4 * (lane >> 4);
        const u32x2v uw = *(const GAS u32x2v*)(F.U + r * 1024 + h0);
        LDS_BARRIER();
        if (MODE == 0) {
            float locr[16], loci[16];
            f32x2v b[16];
#pragma unroll
            for (int k = 0; k < 16; ++k) b[k] = *(const LAS f32x2v*)(lds + S5L_BU + ((16 * w + k) * 128 + 2 * p) * 4);
            float xr = 0.f, xi = 0.f;
#pragma unroll
            for (int k = 0; k < 16; ++k) { const float nr = lr * xr - li * xi + b[k].x, ni = lr * xi + li * xr + b[k].y; xr = nr; xi = ni; locr[k] = xr; loci[k] = xi; }
            *(LAS f32x2v*)(lds + S5L_EX + (w * 64 + p) * 8) = (f32x2v){xr, xi};
            LDS_BARRIER();
            float cr = Xr, ci = Xi, Cwr = 0.f, Cwi = 0.f;
#pragma unroll
            for (int ww = 0; ww < 8; ++ww) {
                if (ww == w) { Cwr = cr; Cwi = ci; }
                const f32x2v e = *(const LAS f32x2v*)(lds + S5L_EX + (ww * 64 + p) * 8);
                const float nr = l16r * cr - l16i * ci + e.x, ni = l16r * ci + l16i * cr + e.y; cr = nr; ci = ni;
            }
            Xr = cr; Xi = ci;
#pragma unroll
            for (int k = 0; k < 16; ++k) {
                const float fr = locr[k] + pwr[k] * Cwr - pwi[k] * Cwi, fi = loci[k] + pwr[k] * Cwi + pwi[k] * Cwr;
                *(LAS unsigned*)(lds + S5L_XS + 4096 * w + 256 * k + (xlane ^ (16 * (((k & 3) << 2) | ((k >> 2) & 3)))) ) = cvtpk(fr, fi);
            }
        } else {
#pragma unroll
            for (int s2 = 0; s2 < 2; ++s2) {
                const int seq = 16 * idx + 2 * w + s2;
                float xr = F.st_re[((size_t)seq * 64 + g) * 64 + p], xi = F.st_im[((size_t)seq * 64 + g) * 64 + p];
#pragma unroll
                for (int k = 0; k < 8; ++k) {
                    const int tl = 16 * w + 8 * s2 + k;
                    const f32x2v b = *(const LAS f32x2v*)(lds + S5L_BU + (tl * 128 + 2 * p) * 4);
                    const float nr = lr * xr - li * xi + b.x, ni = lr * xi + li * xr + b.y; xr = nr; xi = ni;
                    *(LAS unsigned*)(lds + S5L_XS + 4096 * w + 256 * (8 * s2 + k) + (xlane ^ (16 * ((((8 * s2 + k) & 3) << 2) | (((8 * s2 + k) >> 2) & 3))))) = cvtpk(xr, xi);
                }
                F.o_s5re_s[((size_t)seq * 64 + g) * 64 + p] = xr; F.o_s5im_s[((size_t)seq * 64 + g) * 64 + p] = xi;
            }
        }
        LDS_BARRIER();
        f32x4 ya = {0.f, 0.f, 0.f, 0.f};
#pragma unroll
        for (int s = 0; s < 4; ++s) {
            const bf16x8 xf = *(const LAS bf16x8*)(lds + S5L_XS + offb(16 * w + (lane & 15), 4 * s + (lane >> 4)));
            ya = __builtin_amdgcn_mfma_f32_16x16x32_bf16(cf[s], xf, ya, 0, 0, 0);
        }
        const float y0 = gelu_tanh(ya[0] + dreg[0] * bflo(uw.x)), y1 = gelu_tanh(ya[1] + dreg[1] * bfhi(uw.x));
        const float y2 = gelu_tanh(ya[2] + dreg[2] * bflo(uw.y)), y3 = gelu_tanh(ya[3] + dreg[3] * bfhi(uw.y));
        u32x2v yo; yo.x = cvtpk(y0, y1); yo.y = cvtpk(y2, y3);
        *(GAS u32x2v*)(F.YS5 + r * 1024 + h0) = yo;
    }
    if (MODE == 0 && w == 0) { F.o_s5re_p[((size_t)idx * 64 + g) * 64 + p] = Xr; F.o_s5im_p[((size_t)idx * 64 + g) * 64 + p] = Xi; }
}

constexpr int S5G_UI = 0, S5G_HX = 65536;
__device__ __forceinline__ void s5_prompt_gemm(Frame& F, const int g, const int n) {
    LAS unsigned char* lds = F.lds;
    const int tid = F.tid, lane = F.lane, w = F.wave, p = lane;
    const size_t rowbase = (size_t)n * 2048;
#pragma unroll
    for (int i = 0; i < 8; ++i) { const int q = tid + 512 * i, token = q >> 1, half = q & 1, c = token >> 4, s_ = token & 15;
        const v4u v = *(const GAS v4u*)(F.U + (rowbase + token) * 1024 + 16 * g + 8 * half);
        *(LAS v4u*)(lds + S5G_UI + 512 * c + 16 * ((2 * s_ + half) ^ (c & 15))) = v; }
    bf16x8 hf[8];
#pragma unroll
    for (int s = 0; s < 8; ++s) hf[s] = *(const GAS bf16x8*)(F.S5Hm + ((size_t)g * 128 + 16 * w + (lane & 15)) * 256 + 32 * s + 8 * (lane >> 4));
    const float lr = F.LBR[g * 64 + p], li = F.LBI[g * 64 + p];
    LDS_BARRIER();
#pragma unroll 2
    for (int ct = 0; ct < 8; ++ct) {
        f32x4 a = {0.f, 0.f, 0.f, 0.f};
        const int c = 16 * ct + (lane & 15);
#pragma unroll
        for (int s = 0; s < 8; ++s) {
            const bf16x8 uf = *(const LAS bf16x8*)(lds + S5G_UI + 512 * c + 16 * ((4 * s + (lane >> 4)) ^ (lane & 15)));
            a = __builtin_amdgcn_mfma_f32_16x16x32_bf16(hf[s], uf, a, 0, 0, 0);
        }
        *(LAS f32x4*)(lds + S5G_HX + 512 * c + 4 * (16 * w + 4 * (lane >> 4))) = a;
    }
    const int t0 = w, t1 = 15 - w;
    bf16x8 l0[8], l1[8], g0[4], g1[4];
#pragma unroll
    for (int s = 0; s < 8; ++s) { l0[s] = *(const GAS bf16x8*)(F.S5Lm + ((size_t)g * 256 + 16 * t0 + (lane & 15)) * 256 + 32 * s + 8 * (lane >> 4));
                                  l1[s] = *(const GAS bf16x8*)(F.S5Lm + ((size_t)g * 256 + 16 * t1 + (lane & 15)) * 256 + 32 * s + 8 * (lane >> 4)); }
#pragma unroll
    for (int s = 0; s < 4; ++s) { g0[s] = *(const GAS bf16x8*)(F.S5Gm + ((size_t)g * 256 + 16 * t0 + (lane & 15)) * 128 + 32 * s + 8 * (lane >> 4));
                                  g1[s] = *(const GAS bf16x8*)(F.S5Gm + ((size_t)g * 256 + 16 * t1 + (lane & 15)) * 128 + 32 * s + 8 * (lane >> 4)); }
    LDS_BARRIER();
    if (w == 0) {
        float Lr = lr, Li = li;
#pragma unroll
        for (int k = 0; k < 4; ++k) { const float nr = Lr * Lr - Li * Li, ni = 2.f * Lr * Li; Lr = nr; Li = ni; }
        float xr = 0.f, xi = 0.f;
        const int xlane = 16 * (p >> 2) + 4 * (p & 3);
        for (int c8 = 0; c8 < 128; c8 += 8) {
            f32x2v b[8];
#pragma unroll
            for (int k = 0; k < 8; ++k) b[k] = *(const LAS f32x2v*)(lds + S5G_HX + 512 * (c8 + k) + 8 * p);
#pragma unroll
            for (int k = 0; k < 8; ++k) {
                const int cc = c8 + k;
                *(LAS unsigned*)(lds + S5G_HX + 256 * cc + (xlane ^ (16 * (((cc & 3) << 2) | ((cc >> 2) & 3))))) = cvtpk(xr, xi);
                const float nr = Lr * xr - Li * xi + b[k].x, ni = Lr * xi + Li * xr + b[k].y; xr = nr; xi = ni;
            }
        }
        F.o_s5re_p[((size_t)n * 64 + g) * 64 + p] = xr; F.o_s5im_p[((size_t)n * 64 + g) * 64 + p] = xi;
    }
    LDS_BARRIER();
#pragma unroll 1
    for (int ct = 0; ct < 8; ++ct) {
        f32x4 a0 = {0.f, 0.f, 0.f, 0.f}, a1 = {0.f, 0.f, 0.f, 0.f};
        const int c = 16 * ct + (lane & 15);
#pragma unroll
        for (int s = 0; s < 8; ++s) {
            const bf16x8 uf = *(const LAS bf16x8*)(lds + S5G_UI + 512 * c + 16 * ((4 * s + (lane >> 4)) ^ (lane & 15)));
            a0 = __builtin_amdgcn_mfma_f32_16x16x32_bf16(l0[s], uf, a0, 0, 0, 0);
            a1 = __builtin_amdgcn_mfma_f32_16x16x32_bf16(l1[s], uf, a1, 0, 0, 0);
        }
#pragma unroll
        for (int s = 0; s < 4; ++s) {
            const bf16x8 xf = *(const LAS bf16x8*)(lds + S5G_HX + offb(c, 4 * s + (lane >> 4)));
            a0 = __builtin_amdgcn_mfma_f32_16x16x32_bf16(g0[s], xf, a0, 0, 0, 0);
            a1 = __builtin_amdgcn_mfma_f32_16x16x32_bf16(g1[s], xf, a1, 0, 0, 0);
        }
        const int h0 = 16 * g + 4 * (lane >> 4);
        { u32x2v yo; yo.x = cvtpk(gelu_tanh(a0[0]), gelu_tanh(a0[1])); yo.y = cvtpk(gelu_tanh(a0[2]), gelu_tanh(a0[3]));
          *(GAS u32x2v*)(F.YS5 + (rowbase + 16 * c + t0) * 1024 + h0) = yo; }
        { u32x2v yo; yo.x = cvtpk(gelu_tanh(a1[0]), gelu_tanh(a1[1])); yo.y = cvtpk(gelu_tanh(a1[2]), gelu_tanh(a1[3]));
          *(GAS u32x2v*)(F.YS5 + (rowbase + 16 * c + t1) * 1024 + h0) = yo; }
    }
}

constexpr int RL_K = 0, RL_V = 65536, RL_P = 73728, RL_RT = 106496;
__device__ __forceinline__ void ret_prompt_item(Frame& F, const int n, const int h, const int part) {
    LAS unsigned char* lds = F.lds;
    const int tid = F.tid, lane = F.lane, w = F.wave;
    const float gam = 1.f - exp2f(-5.f - (float)h);
    const float cd = exp2f(128.f * __log2f(gam));
    LAS unsigned char* P = lds + RL_P + w * 4096;
#pragma unroll
    for (int i = 0; i < 4; ++i) *(LAS v4u*)(P + lane * 16 + i * 1024) = (v4u){0u, 0u, 0u, 0u};
    if (tid < 256) *(LAS v4u*)(lds + RL_RT + tid * 16) = (v4u){0u, 0u, 0u, 0u};
    const unsigned lq = (unsigned)(lane & 15) >> 2, lp = (unsigned)lane & 3u, lg = (unsigned)lane >> 4;
    const unsigned fl = ((unsigned)(lane & 3) << 2) | ((unsigned)(lane >> 2) & 3u);
    unsigned kx[4];
#pragma unroll
    for (int s = 0; s < 4; ++s) kx[s] = 256u * (unsigned)(lane & 15) + 16u * ((4u * s + lg) ^ fl);
    const unsigned pwbase = 256u * (unsigned)(lane & 15) + 8u * (lg & 1u), pl16 = 16u * (((unsigned)lane >> 5) ^ fl);
    const unsigned vb0 = lg * 256u + lq * 32u + lp * 8u, vh = (lg & 1u) * 128u;
    unsigned kso[4];
#pragma unroll
    for (int i = 0; i < 4; ++i) { const unsigned row = 4u * (4u * w + i) + lg, ch = (unsigned)(lane & 15) ^ ((lg << 2) | (unsigned)i); kso[i] = (row * 1024u + 8u * ch) * 2u; }
    const size_t rowbase = (size_t)n * 2048;
    const char* kbase = (const char*)(F.Kb + rowbase * 1024 + h * 128);
    const bf16* vsrc = F.V + (rowbase + (tid >> 2)) * 1024 + h * 128 + 16 * part + 4 * (tid & 3);
    const unsigned vdst = (unsigned)((tid >> 5) * 256 + ((((tid >> 4) & 1) ^ ((tid >> 5) & 1)) * 128) + ((tid >> 2) & 3) * 32 + (tid & 3) * 8);
    const bf16* qsrc = F.Q + (rowbase + 16 * w + (lane & 15)) * 1024 + h * 128 + 8 * lg;
    v4u kreg[4];
#define RP_KLOAD(c_) do { _Pragma("unroll") for (int _i = 0; _i < 4; ++_i) kreg[_i] = *(const GAS v4u*)(kbase + (size_t)(c_) * (128 * 1024 * 2) + kso[_i]); } while (0)
    RP_KLOAD(0);
    u32x2v vreg = *(const GAS u32x2v*)(vsrc);
    bf16x8 qn[4];
#pragma unroll
    for (int s = 0; s < 4; ++s) qn[s] = *(const GAS bf16x8*)(qsrc + 32 * s);
    f32x4 accR = {0.f, 0.f, 0.f, 0.f};
    u32x2v opend = {0u, 0u};
    for (int c = 0; c < 16; ++c) {
        *(LAS u32x2v*)(lds + RL_V + (c & 1) * 4096 + vdst) = vreg;
#pragma unroll
        for (int i = 0; i < 4; ++i) *(LAS v4u*)(lds + RL_K + (c & 1) * 32768 + (4 * w + i) * 1024 + lane * 16) = kreg[i];
        LDS_BARRIER();
        bf16x8 qf[4];
#pragma unroll
        for (int s = 0; s < 4; ++s) qf[s] = qn[s];
        if (c < 15) {
            RP_KLOAD(c + 1);
            vreg = *(const GAS u32x2v*)(vsrc + (size_t)(c + 1) * 128 * 1024);
#pragma unroll
            for (int s = 0; s < 4; ++s) qn[s] = *(const GAS bf16x8*)(qsrc + (size_t)(c + 1) * 128 * 1024 + 32 * s);
        }
        asm volatile("" ::: "memory");
        if (c > 0) *(GAS u32x2v*)(F.Ob + (rowbase + 128 * (c - 1) + 16 * w + (lane & 15)) * 1024 + h * 128 + 16 * part + 4 * lg) = opend;
        asm volatile("" ::: "memory");
        LAS unsigned char* KI = lds + RL_K + (c & 1) * 32768;
        LAS unsigned char* VI = lds + RL_V + (c & 1) * 4096;
        {
            bf16x8 kfc[4], kfn[4];
#pragma unroll
            for (int s = 0; s < 4; ++s) { kfc[s] = *(const LAS bf16x8*)(KI + kx[s]); kfn[s] = kfc[s]; }
            for (int cb = 0; cb <= w; ++cb) {
                if (cb < w) {
#pragma unroll
                    for (int s = 0; s < 4; ++s) kfn[s] = *(const LAS bf16x8*)(KI + 4096 * (cb + 1) + kx[s]);
                }
                f32x4 st = {0.f, 0.f, 0.f, 0.f};
#pragma unroll
                for (int s = 0; s < 4; ++s) st = __builtin_amdgcn_mfma_f32_16x16x32_bf16(kfc[s], qf[s], st, 0, 0, 0);
                if (cb == w) {
#pragma unroll
                    for (int e = 0; e < 4; ++e) if ((int)(4 * lg) + e > (lane & 15)) st[e] = 0.f;
                }
                u32x2v pw; pw.x = cvtpk(st[0], st[1]); pw.y = cvtpk(st[2], st[3]);
                *(LAS u32x2v*)(P + pwbase + ((32u * (unsigned)cb) ^ pl16)) = pw;
#pragma unroll
                for (int s = 0; s < 4; ++s) kfc[s] = kfn[s];
            }
        }
        bf16x8 vf[4], kt[4];
#pragma unroll
        for (int s = 0; s < 4; ++s) {
            vf[s] = tr_pair(VI, 1024u * s + vb0 + vh, 1024u * s + vb0 + (vh ^ 128u));
            const unsigned r0 = 32 * s + 8 * lg + lq;
            kt[s] = tr_pair(KI, offb(r0, 2 * w + (lp >> 1)) + 8 * (lp & 1), offb(r0 + 4, 2 * w + (lp >> 1)) + 8 * (lp & 1));
        }
        f32x4 oi = {0.f, 0.f, 0.f, 0.f}, oc = {0.f, 0.f, 0.f, 0.f};
#pragma unroll
        for (int s = 0; s < 4; ++s) {
            const bf16x8 pf = *(const LAS bf16x8*)(P + kx[s]);
            oi = __builtin_amdgcn_mfma_f32_16x16x32_bf16(vf[s], pf, oi, 0, 0, 0);
            const bf16x8 rf = *(const LAS bf16x8*)(lds + RL_RT + (c & 1) * 4096 + kx[s]);
            oc = __builtin_amdgcn_mfma_f32_16x16x32_bf16(rf, qf[s], oc, 0, 0, 0);
        }
        accR = accR * cd;
#pragma unroll
        for (int s = 0; s < 4; ++s) accR = __builtin_amdgcn_mfma_f32_16x16x32_bf16(kt[s], vf[s], accR, 0, 0, 0);
        { u32x2v rw; rw.x = cvtpk(accR[0], accR[1]); rw.y = cvtpk(accR[2], accR[3]);
          *(LAS u32x2v*)(lds + RL_RT + ((c + 1) & 1) * 4096 + pwbase + ((32u * (unsigned)w) ^ pl16)) = rw; }
        { const f32x4 o = oi + oc * cd; opend.x = cvtpk(o[0], o[1]); opend.y = cvtpk(o[2], o[3]); }
    }
    *(GAS u32x2v*)(F.Ob + (rowbase + 128 * 15 + 16 * w + (lane & 15)) * 1024 + h * 128 + 16 * part + 4 * lg) = opend;
#undef RP_KLOAD
#pragma unroll
    for (int e = 0; e < 4; ++e) F.o_ret_p[(((size_t)n * 8 + h) * 128 + 16 * w + 4 * lg + e) * 128 + 16 * part + (lane & 15)] = accR[e];
    LDS_BARRIER();
}

constexpr int SL_Q = 0, SL_K = 4096, SL_SC = 8192, SL_OCP = 8704;
__device__ __forceinline__ void ret_sample_item(Frame& F, const int n, const int h) {
    LAS unsigned char* lds = F.lds;
    const int tid = F.tid, e = tid & 127, dq = tid >> 7;
    const float gam = 1.f - exp2f(-5.f - (float)h), l2g = __log2f(gam);
    const size_t rbase = ((size_t)n * 8 + h) * 128 * 128;
    const int row0 = 8192 + 8 * n;
    float R[32];
#pragma unroll
    for (int dd = 0; dd < 32; ++dd) R[dd] = F.st_ret[rbase + (size_t)(32 * dq + dd) * 128 + e];
#pragma unroll
    for (int i = 0; i < 2; ++i) { const int q = tid + 512 * i, t = q >> 7, d = q & 127;
        const size_t o = (size_t)(row0 + t) * 1024 + h * 128 + d;
        *(LAS float*)(lds + SL_Q + q * 4) = bflo((unsigned)F.Q[o]);
        *(LAS float*)(lds + SL_K + q * 4) = bflo((unsigned)F.Kb[o]) * exp2f(l2g * (float)(7 - t)); }
    float v[8];
#pragma unroll
    for (int t = 0; t < 8; ++t) v[t] = bflo((unsigned)F.V[(size_t)(row0 + t) * 1024 + h * 128 + e]);
    LDS_BARRIER();
    if (tid < 64) { const int i = tid >> 3, j = tid & 7; float s = 0.f;
        if (j <= i) { for (int d = 0; d < 128; ++d) s += *(const LAS float*)(lds + SL_Q + (i * 128 + d) * 4) * *(const LAS float*)(lds + SL_K + (j * 128 + d) * 4); s *= exp2f(l2g * (float)(i - 7)); }
        *(LAS float*)(lds + SL_SC + tid * 4) = s; }
    float oc[8];
#pragma unroll
    for (int t = 0; t < 8; ++t) oc[t] = 0.f;
    const float g8 = exp2f(8.f * l2g);
#pragma unroll
    for (int d4 = 0; d4 < 8; ++d4) {
        f32x4 qv[8], kv[8];
#pragma unroll
        for (int t = 0; t < 8; ++t) { qv[t] = *(const LAS f32x4*)(lds + SL_Q + (t * 128 + 32 * dq + 4 * d4) * 4); kv[t] = *(const LAS f32x4*)(lds + SL_K + (t * 128 + 32 * dq + 4 * d4) * 4); }
#pragma unroll
        for (int k = 0; k < 4; ++k) {
            const int dd = 4 * d4 + k; const float r = R[dd]; float rn = g8 * r;
#pragma unroll
            for (int t = 0; t < 8; ++t) { oc[t] += qv[t][k] * r; rn += kv[t][k] * v[t]; }
            R[dd] = rn;
        }
        asm volatile("" ::: "memory");
    }
#pragma unroll
    for (int dd = 0; dd < 32; ++dd) F.o_ret_s[rbase + (size_t)(32 * dq + dd) * 128 + e] = R[dd];
#pragma unroll
    for (int t = 0; t < 8; ++t) *(LAS float*)(lds + SL_OCP + ((dq * 8 + t) * 128 + e) * 4) = oc[t];
    LDS_BARRIER();
#pragma unroll
    for (int k = 0; k < 2; ++k) { const int t = 2 * dq + k;
        float o = 0.f;
#pragma unroll
        for (int qq = 0; qq < 4; ++qq) o += *(const LAS float*)(lds + SL_OCP + ((qq * 8 + t) * 128 + e) * 4);
        o *= exp2f(l2g * (float)(t + 1));
#pragma unroll
        for (int j = 0; j < 8; ++j) if (j <= t) o += *(const LAS float*)(lds + SL_SC + (t * 8 + j) * 4) * v[j];
        F.Ob[(size_t)(row0 + t) * 1024 + h * 128 + e] = (bf16)f2bf(o); }
    LDS_BARRIER();
}

__device__ __forceinline__ void ret_norm_rows(Frame& F, int first, int stride) {
    const int lane = F.lane, col = (lane >> 3) * 128 + (lane & 7) * 16;
    f32x4 gw[4];
#pragma unroll
    for (int i = 0; i < 4; ++i) gw[i] = *(const GAS f32x4*)(F.gn_w + col + 4 * i);
    for (int r0 = first; r0 < MROWS; r0 += 2 * stride) {
        v4u ow[2][2], gv[2][2];
#pragma unroll
        for (int k = 0; k < 2; ++k) { const int r = r0 + k * stride;
            if (r < MROWS) {
#pragma unroll
                for (int i = 0; i < 2; ++i) { ow[k][i] = *(const GAS v4u*)(F.Ob + (size_t)r * 1024 + col + 8 * i); gv[k][i] = *(const GAS v4u*)(F.Gt + (size_t)r * 1024 + col + 8 * i); } } }
#pragma unroll
        for (int k = 0; k < 2; ++k) { const int r = r0 + k * stride;
            if (r < MROWS) {
                float x[16], g[16];
#pragma unroll
                for (int i = 0; i < 2; ++i)
#pragma unroll
                    for (int j = 0; j < 4; ++j) { x[8 * i + 2 * j] = bflo(ow[k][i][j]); x[8 * i + 2 * j + 1] = bfhi(ow[k][i][j]); g[8 * i + 2 * j] = bflo(gv[k][i][j]); g[8 * i + 2 * j + 1] = bfhi(gv[k][i][j]); }
                float s = 0.f;
#pragma unroll
                for (int j = 0; j < 16; ++j) s += x[j];
                s += __shfl_xor(s, 1); s += __shfl_xor(s, 2); s += __shfl_xor(s, 4);
                const float mu = s * (1.f / 128.f);
                float q = 0.f;
#pragma unroll
                for (int j = 0; j < 16; ++j) { x[j] -= mu; q += x[j] * x[j]; }
                q += __shfl_xor(q, 1); q += __shfl_xor(q, 2); q += __shfl_xor(q, 4);
                const float rs = rsqrtf(q * (1.f / 128.f) + 1e-6f);
                v4u o[2];
#pragma unroll
                for (int i = 0; i < 2; ++i)
#pragma unroll
                    for (int j = 0; j < 4; ++j) { const int e = 8 * i + 2 * j; o[i][j] = pk2(g[e] * (x[e] * rs * gw[e >> 2][e & 3]), g[e + 1] * (x[e + 1] * rs * gw[(e + 1) >> 2][(e + 1) & 3])); }
#pragma unroll
                for (int i = 0; i < 2; ++i) *(GAS v4u*)(F.MIX + (size_t)r * 2048 + 1024 + col + 8 * i) = o[i];
            } }
    }
}
__device__ __forceinline__ void sample_rows_reduce(Frame& F, const bf16* slab, float* ss) {
    const int gwv = (int)blockIdx.x * NWAVES + F.wave, NGW = F.G * NWAVES, lane = F.lane;
    for (int m = 8192 + gwv; m < MROWS; m += NGW) {
        const GAS v4u* xr = (const GAS v4u*)(F.XN + (size_t)m * 2048) + lane;
        f32x4 v[8]; float s = 0.f;
#pragma unroll
        for (int j = 0; j < 4; ++j) { const v4u w = xr[64 * j];
            v[2 * j] = (f32x4){bflo(w.x), bfhi(w.x), bflo(w.y), bfhi(w.y)}; v[2 * j + 1] = (f32x4){bflo(w.z), bfhi(w.z), bflo(w.w), bfhi(w.w)}; }
#pragma unroll 2
        for (int k = 0; k < 8; ++k) {
            const GAS v4u* sr = (const GAS v4u*)(slab + ((size_t)k * 1024 + (m - 8192)) * 2048) + lane;
#pragma unroll
            for (int j = 0; j < 4; ++j) { const v4u w = sr[64 * j];
                v[2 * j] += (f32x4){bflo(w.x), bfhi(w.x), bflo(w.y), bfhi(w.y)}; v[2 * j + 1] += (f32x4){bflo(w.z), bfhi(w.z), bflo(w.w), bfhi(w.w)}; }
        }
        GAS v4u* o16 = (GAS v4u*)(F.XN + (size_t)m * 2048) + lane;
#pragma unroll
        for (int j = 0; j < 4; ++j) { const f32x4 a = v[2 * j], c = v[2 * j + 1];
            s += ((a.x * a.x + a.y * a.y) + (a.z * a.z + a.w * a.w)) + ((c.x * c.x + c.y * c.y) + (c.z * c.z + c.w * c.w));
            v4u o; o.x = pk2(a.x, a.y); o.y = pk2(a.z, a.w); o.z = pk2(c.x, c.y); o.w = pk2(c.z, c.w); o16[64 * j] = o; }
        s = wave_sum(s);
        if (lane == 0) ss[m] = s;
    }
}
__device__ __forceinline__ void final_norm(Frame& F, const bf16* slab) {
    const int gwv = (int)blockIdx.x * NWAVES + F.wave, NGW = F.G * NWAVES, lane = F.lane;
    for (int m = gwv; m < MROWS; m += NGW) {
        const GAS v4u* xr = (const GAS v4u*)(F.XN + (size_t)m * 2048) + lane;
        f32x4 v[8];
#pragma unroll
        for (int j = 0; j < 4; ++j) { const v4u w = xr[64 * j];
            v[2 * j] = (f32x4){bflo(w.x), bfhi(w.x), bflo(w.y), bfhi(w.y)}; v[2 * j + 1] = (f32x4){bflo(w.z), bfhi(w.z), bflo(w.w), bfhi(w.w)}; }
        if (m >= 8192) {
#pragma unroll 2
            for (int k = 0; k < 8; ++k) {
                const GAS v4u* sr = (const GAS v4u*)(slab + ((size_t)k * 1024 + (m - 8192)) * 2048) + lane;
#pragma unroll
                for (int j = 0; j < 4; ++j) { const v4u w = sr[64 * j];
                    v[2 * j] += (f32x4){bflo(w.x), bfhi(w.x), bflo(w.y), bfhi(w.y)}; v[2 * j + 1] += (f32x4){bflo(w.z), bfhi(w.z), bflo(w.w), bfhi(w.w)}; }
            }
        }
        float s = 0.f;
#pragma unroll
        for (int j = 0; j < 8; ++j) s += (v[j].x * v[j].x + v[j].y * v[j].y) + (v[j].z * v[j].z + v[j].w * v[j].w);
        const float sc = rsqrtf(wave_sum(s) * (1.f / 2048.f) + 1e-6f);
        GAS f32x4* yr = (GAS f32x4*)(F.Y + (size_t)m * 2048) + 2 * lane;
        const GAS f32x4* gr = (const GAS f32x4*)F.norm_final + 2 * lane;
#pragma unroll
        for (int j = 0; j < 4; ++j) { yr[128 * j] = v[2 * j] * sc * gr[128 * j]; yr[128 * j + 1] = v[2 * j + 1] * sc * gr[128 * j + 1]; }
    }
}

struct Args { const float* in[23]; float* out; unsigned char* ws; int ph_lo, ph_hi, li, pad; };
__global__ void __launch_bounds__(NWAVES * 64, 2) mk_fwd(Args args) {
    extern __shared__ __attribute__((aligned(16))) unsigned char lds[];
    Frame F;
    F.lds = (LAS unsigned char*)lds;
    F.MISC = (volatile LAS unsigned*)(F.lds + MISC_OFF);
    F.tid = threadIdx.x; F.lane = F.tid & 63; F.wave = __builtin_amdgcn_readfirstlane(F.tid >> 6);
    F.G = gridDim.x;
    unsigned char* ws = args.ws;
    F.ctl = (gu32*)(ws + WS_CTL);
    F.x_prompt = args.in[0]; F.x_sample = args.in[1]; F.st_re = args.in[2]; F.st_im = args.in[3]; F.st_ret = args.in[4]; F.norm_mix = args.in[5]; F.w_in = args.in[6];
    F.lam_re = args.in[7]; F.lam_im = args.in[8]; F.log_step = args.in[9]; F.b_re = args.in[10]; F.b_im = args.in[11]; F.c_re = args.in[12]; F.c_im = args.in[13];
    F.s5_d = args.in[14]; F.w_glu = args.in[15]; F.b_glu = args.in[16]; F.gn_w = args.in[17]; F.w_out = args.in[18]; F.norm_ffn = args.in[19]; F.w_ffn_in = args.in[20];
    F.w_ffn_out = args.in[21]; F.norm_final = args.in[22];
    F.Y = args.out;
    F.o_s5re_p = F.Y + (size_t)MROWS * 2048; F.o_s5im_p = F.o_s5re_p + 4 * 64 * 64; F.o_ret_p = F.o_s5im_p + 4 * 64 * 64;
    F.o_s5re_s = F.o_ret_p + (size_t)4 * 8 * 128 * 128; F.o_s5im_s = F.o_s5re_s + (size_t)128 * 64 * 64; F.o_ret_s = F.o_s5im_s + (size_t)128 * 64 * 64;
    F.LBR = (float*)(ws + WS_PAR); F.LBI = F.LBR + 4096; F.ROPEC = F.LBI + 4096; F.ROPES = F.ROPEC + 2056 * 64;
    F.SS0 = (float*)(ws + WS_PAR + 1736704);
    F.BB = (bf16*)(ws + WS_PAR + 1179648); F.CMT = F.BB + 64 * 128 * 16;
    F.WIN_T = (bf16*)(ws + WS_WIN); F.WGLU_T = (bf16*)(ws + WS_WGLU); F.WOUT_T = (bf16*)(ws + WS_WOUT); F.WFI_T = (bf16*)(ws + WS_WFI); F.WFO_T = (bf16*)(ws + WS_WFO);
    F.XN = (bf16*)(ws + WS_XN); F.U = (bf16*)(ws + WS_U); F.Q = (bf16*)(ws + WS_Q); F.Kb = (bf16*)(ws + WS_K); F.V = (bf16*)(ws + WS_V); F.Gt = (bf16*)(ws + WS_G);
    F.S5Lm = (bf16*)(ws + WS_S5L); F.S5Hm = (bf16*)(ws + WS_S5H); F.S5Gm = (bf16*)(ws + WS_S5G);
    F.Ob = (bf16*)(ws + WS_O); F.YS5 = (bf16*)(ws + WS_YS5); F.MIX = (bf16*)(ws + WS_MIX); F.ACT = (bf16*)(ws + WS_ACT);
    for (int u = F.tid; u < (LDS_BYTES - LDSCTL_OFF) / 4; u += NWAVES * 64) ((LAS unsigned*)(F.lds + LDSCTL_OFF))[u] = 0u;
    __syncthreads();
    XcdBarrier bar; bar.bar = (unsigned*)(F.ctl + CW_BAR); bar.x = 0; bar.st = nullptr;
    if (N_LAUNCHES == 1) bar = xcd_barrier_post((unsigned*)(F.ctl + CW_BAR), F.MISC + 8);
#define GRID_BAR() do { if (N_LAUNCHES == 1) xcd_barrier(bar); } while (0)
    const int lo = args.ph_lo, hi = args.ph_hi;
#define IN(k) (lo <= (k) && (k) < hi)
#define BOTH(k) (IN(k) && IN((k) + 1))
    const int bx = (int)blockIdx.x;

    if (IN(0)) { p0_prologue(F); if (BOTH(0)) GRID_BAR(); }

    if (IN(1)) {
        pg8::Gemm g{F.XN, F.WIN_T, MROWS, 5120, 2048}; pg8::StaticOrder S; S.init(MROWS, 5120, 2048, F.G, bx);
        pg8::EpiProj E{F.U, F.ROPEC, F.ROPES, F.SS0};
        pg8::gemm_phase<pg8::EpiProj, pg8::StaticOrder, PG8_ALIGN, PG8_SP2>(F.lds, g, S, E);
        {
            const int nlast = 720 - (720 / F.G) * F.G, nfree = F.G - nlast;
            __syncthreads();
            if (nlast == 0 || nfree <= 0) { for (int gg = bx; gg < 64; gg += F.G) s5_precompute(F, gg); }
            else if (bx >= nlast) { for (int gg = bx - nlast; gg < 64; gg += nfree) s5_precompute(F, gg); }
        }
        if (BOTH(1)) GRID_BAR();
    }

    if (IN(2)) {
        __syncthreads();
        for (int it = bx; it < 256; it += F.G) { s5_prompt_gemm(F, ((it & 7) << 3) | ((it >> 3) & 7), it >> 6); __syncthreads(); }
        for (int it = bx; it < 512; it += F.G) { s5_item<1>(F, ((it & 7) << 3) | ((it >> 3) & 7), it >> 6); __syncthreads(); }
        for (int it = bx; it < 256; it += F.G) {
            const int xcd = it & 7, slot = it >> 3, part = slot & 7, nh = xcd + 8 * (slot >> 3);
            ret_prompt_item(F, nh >> 3, nh & 7, part); __syncthreads(); }
        for (int it = bx; it < 1024; it += F.G) ret_sample_item(F, it >> 3, it & 7);
        if (BOTH(2)) GRID_BAR();
    }

    if (IN(3)) {
        pg8::StaticOrder S; S.init(MROWS, 1024, 1024, F.G, bx);
        pg8::Unit u0;
        if (S.next(0, u0)) {
            pg8::Gemm g{F.YS5, F.WGLU_T, MROWS, 1024, 1024};
            pg8::EpiGlu E{F.YS5, F.MIX, F.b_glu};
            pg8::gemm_phase<pg8::EpiGlu, pg8::StaticOrder, PG8_ALIGN, PG8_SP2>(F.lds, g, S, E);
        } else {
            const int nfree = F.G - 144;
            ret_norm_rows(F, (bx - 144) * NWAVES + F.wave, nfree * NWAVES);
            p0_convert_items(F, NITEMS - I_FO + I_FO_P0, NITEMS, (bx - 144) * NWAVES + F.wave, nfree * NWAVES, (LAS float*)(F.lds + F.wave * 16384));
        }
        if (F.G <= 144) { ret_norm_rows(F, bx * NWAVES + F.wave, F.G * NWAVES); p0_convert_items(F, NITEMS - I_FO + I_FO_P0, NITEMS, bx * NWAVES + F.wave, F.G * NWAVES, (LAS float*)(F.lds + F.wave * 16384)); }
        if (BOTH(3)) GRID_BAR();
    }

    if (IN(4)) {
        pg8::Gemm g{F.MIX, F.WOUT_T, MROWS, 2048, 2048}; pg8::SplitOrder S; S.init(2048, F.G, bx);
        pg8::EpiResid<0> E{F.XN, (bf16*)(ws + WS_SLAB4), (float*)(ws + WS_SS)};
        pg8::gemm_phase<pg8::EpiResid<0>, pg8::SplitOrder, PG8_ALIGN, PG8_SP2>(F.lds, g, S, E);
        if (BOTH(4)) GRID_BAR();
    }
    if (IN(5)) { sample_rows_reduce(F, (const bf16*)(ws + WS_SLAB4), (float*)(ws + WS_SS)); if (BOTH(5)) GRID_BAR(); }
    if (IN(6)) {
        pg8::Gemm g{F.XN, F.WFI_T, MROWS, 11264, 2048}; pg8::HalfTailOrder S; S.init(MROWS, 11264, 2048, F.G, bx);
        pg8::EpiSwiglu E{F.ACT, 5632, (const float*)(ws + WS_SS)};
        pg8::gemm_phase<pg8::EpiSwiglu, pg8::HalfTailOrder, PG8_ALIGN, PG8_SP2>(F.lds, g, S, E);
        if (BOTH(6)) GRID_BAR();
    }
    if (IN(7)) {
        pg8::Gemm g{F.ACT, F.WFO_T, MROWS, 2048, 5632}; pg8::SplitOrder S; S.init(5632, F.G, bx);
        pg8::EpiResid<1> E{F.XN, (bf16*)(ws + WS_SLAB7), nullptr};
        pg8::gemm_phase<pg8::EpiResid<1>, pg8::SplitOrder, PG8_ALIGN, PG8_SP2>(F.lds, g, S, E);
        if (BOTH(7)) GRID_BAR();
    }
    if (IN(8)) final_norm(F, (const bf16*)(ws + WS_SLAB7));
#undef IN
#undef BOTH
}

extern "C" void kernel_launch(void* const* d_in, const int* in_sizes, int n_in, void* d_out, int out_size, void* d_ws, size_t ws_size, hipStream_t stream) {
    static int grid = 0;
    if (grid == 0) {
        if (n_in != 23 || ws_size < WS_END) { fprintf(stderr, "kernel_launch: expected 23 inputs and >= %zu bytes of workspace (got %d, %zu)\n", (size_t)WS_END, n_in, ws_size); grid = -1; return; }
        int dev = 0, cus = 0, per_cu = 0;
        if (hipGetDevice(&dev) != hipSuccess || hipDeviceGetAttribute(&cus, hipDeviceAttributeMultiprocessorCount, dev) != hipSuccess) { grid = -1; return; }
        if (hipFuncSetAttribute((const void*)mk_fwd, hipFuncAttributeMaxDynamicSharedMemorySize, LDS_BYTES) != hipSuccess) { fprintf(stderr, "kernel_launch: hipFuncSetAttribute failed\n"); grid = -1; return; }
        if (hipOccupancyMaxActiveBlocksPerMultiprocessor(&per_cu, (const void*)mk_fwd, NWAVES * 64, LDS_BYTES) != hipSuccess || per_cu < 1) { fprintf(stderr, "kernel_launch: occupancy query says %d blocks per CU\n", per_cu); grid = -1; (void)hipGetLastError(); return; }
        grid = cus;
        if (cus != 256) fprintf(stderr, "kernel_launch: built for a 256-CU device (static unit orders, split-K slices); this device reports %d CUs: the output will be wrong\n", cus);
    }
    if (grid < 0) return;
    if (hipMemsetAsync((char*)d_ws + WS_CTL, 0, CTL_ZERO_BYTES, stream) != hipSuccess) return;
    Args a{};
    for (int i = 0; i < 23; ++i) a.in[i] = (const float*)d_in[i];
    a.out = (float*)d_out; a.ws = (unsigned char*)d_ws;
    for (int li = 0; li < N_LAUNCHES; ++li) {
        a.ph_lo = (N_LAUNCHES == 1) ? 0 : li; a.ph_hi = (N_LAUNCHES == 1) ? N_PHASES : li + 1; a.li = li;
        void* kargs[] = {&a};
        hipError_t le = hipLaunchCooperativeKernel((const void*)mk_fwd, dim3(grid), dim3(NWAVES * 64), kargs, LDS_BYTES, stream);
        if (le != hipSuccess) { fprintf(stderr, "kernel_launch: launch %d failed: %s\n", li, hipGetErrorName(le)); break; }
    }
}
```

```cpp
#include <hip/hip_runtime.h>
#include <cstdio>
#include <cstdint>
#include <math.h>
#ifndef MK_N_LAUNCHES
#define MK_N_LAUNCHES 1
#endif
constexpr int N_LAUNCHES = MK_N_LAUNCHES;
constexpr int N_PHASES = 9;
constexpr int NWAVES = 8;
constexpr int MROWS = 9216;
constexpr size_t MiB = 1u << 20;
constexpr size_t WS_CTL = 0, CTL_ZERO_BYTES = 72 * 1024;
constexpr size_t WS_PAR = 1 * MiB;
constexpr size_t WS_WIN = 4 * MiB, WS_WGLU = 24 * MiB, WS_WOUT = 26 * MiB, WS_WFI = 34 * MiB, WS_WFO = 78 * MiB;
constexpr size_t WS_XN = 100 * MiB, WS_MIX = 136 * MiB, WS_YS5 = 172 * MiB;
constexpr size_t WS_U = 190 * MiB, WS_Q = 208 * MiB, WS_K = 226 * MiB, WS_V = 244 * MiB, WS_G = 262 * MiB, WS_O = 280 * MiB;
constexpr size_t WS_ACT = 190 * MiB;
constexpr size_t WS_SLAB4 = 190 * MiB;
constexpr size_t WS_SLAB7 = 4 * MiB;
constexpr size_t WS_S5L = 298 * MiB, WS_S5H = 306 * MiB, WS_S5G = 310 * MiB;
constexpr size_t WS_END = 314 * MiB;
constexpr int CW_BAR = 4096;
constexpr size_t WS_SS = 32 * 1024;
constexpr int LDS_BYTES = 147456, LDSCTL_OFF = 139264, MISC_OFF = LDSCTL_OFF + 320;
#ifndef PG8_SP2
#define PG8_SP2 true
#endif
#ifndef PG8_ALIGN
#define PG8_ALIGN true
#endif
namespace pg8 {
#define PG8_LAS __attribute__((address_space(3)))
typedef unsigned short bf16_t;
typedef short bf16x8 __attribute__((ext_vector_type(8)));
typedef float f32x4 __attribute__((ext_vector_type(4)));
typedef unsigned u32x4 __attribute__((ext_vector_type(4)));
constexpr int BM = 256, BK = 64, HALF = 128, HTB = HALF * BK * 2  , STAGE_BYTES = 8 * HTB, NXCD = 8, WGM = 8;

__host__ __device__ __forceinline__ int lds_byte(int r, int c) { const int st = (r >> 4) * 2 + (c >> 5), rr = r & 15, cc = c & 31, ob = rr * 64 + cc * 2; return st * 1024 + (ob ^ (((ob >> 9) & 1) << 5)); }
__host__ __device__ __forceinline__ void stage_rc(int b, int& R, int& C) { const int st = b / 1024, sb = b % 1024, swz = sb ^ (((sb >> 9) & 1) << 5); R = (st >> 1) * 16 + swz / 64; C = (st & 1) * 32 + (swz % 64) / 2; }
__host__ __device__ __forceinline__ int perm32(int rho) { const int n = rho >> 4, i = rho & 15; return 8 * (i >> 2) + 4 * n + (i & 3); }

struct Unit { int pm, pn, kt0, nt, sp, hm, roff; };
struct Gemm { const bf16_t* A; const bf16_t* Bt; int M, N, K; };

struct StaticOrder {
    int nM, nN, nwg, G, c, ntk;
    __host__ __device__ __forceinline__ void init(int M, int N, int K, int G_, int c_) { nM = M / BM; nN = N / BM; nwg = nM * nN; G = G_; c = c_; ntk = K / BK; }
    __host__ __device__ __forceinline__ bool next(int i, Unit& u) const { return map((long)i * G + c, u); }
    __host__ __device__ __forceinline__ bool map(const long L, Unit& u) const {
        if (L >= nwg) return false;
        u.kt0 = 0; u.nt = ntk; u.sp = -1; u.hm = 0; u.roff = 0;
        int wgid = (int)L; { const int q = nwg / NXCD, r = nwg % NXCD, xcd = wgid % NXCD, off = wgid / NXCD; wgid = (xcd < r ? xcd * (q + 1) : r * (q + 1) + (xcd - r) * q) + off; }
        const int nig = WGM * nN, gid = wgid / nig, fm = gid * WGM, gsz = (nM - fm) < WGM ? (nM - fm) : WGM;
        u.pm = fm + ((wgid % nig) % gsz); u.pn = (wgid % nig) / gsz; return true;
    }
    __device__ __forceinline__ void a_ready(const Unit&) const {}
    __device__ __forceinline__ void done(const Unit&) const {}
};

struct HalfTailOrder {
    StaticOrder so; int R, T;
    __host__ __device__ __forceinline__ void init(int M, int N, int K, int G_, int c_) { so.init(M, N, K, G_, c_); R = so.nwg / G_; T = so.nwg - R * G_; }
    __host__ __device__ __forceinline__ bool next(int i, Unit& u) const {
        const bool halves = (i == R) && (2 * T <= so.G);
        if (i > R || (halves && so.c >= 2 * T)) return false;
        const long L = halves ? (long)R * so.G + (so.c >> 1) : (long)i * so.G + so.c;
        const bool ok = so.map(L, u);
        u.hm = halves ? 1 : 0; u.roff = halves ? 128 * (so.c & 1) : 0;
        return ok;
    }
    __device__ __forceinline__ void a_ready(const Unit&) const {}
    __device__ __forceinline__ void done(const Unit&) const {}
};

struct SplitOrder {
    StaticOrder so; int c, ntk;
    __host__ __device__ __forceinline__ void init(int K, int G_, int c_) { so.init(8192, 2048, K, G_, c_); c = c_; ntk = K / BK; }
    __host__ __device__ __forceinline__ bool next(int i, Unit& u) const {
        if (i == 0) return so.next(0, u);
        if (i > 1) return false;
        if (ntk == 32) {
            if (c >= 128) return false;
            const int s = c & 3, ui = c >> 2;
            u.pm = 32 + (ui >> 3); u.pn = ui & 7; u.sp = s; u.hm = 0; u.roff = 0; u.kt0 = 8 * s; u.nt = 8;
            return true;
        }
        const int s = c & 7, ui = c >> 3;
        u.pm = 32 + (ui >> 3); u.pn = ui & 7; u.sp = s; u.hm = 0; u.roff = 0;
        { u.kt0 = 22 * (s >> 1) + 12 * (s & 1); u.nt = (s & 1) ? 10 : 12; }
        return true;
    }
    __device__ __forceinline__ void a_ready(const Unit&) const {}
    __device__ __forceinline__ void done(const Unit&) const {}
};

typedef float cvf32x2_t __attribute__((ext_vector_type(2))); typedef __bf16 cvbf16x2_t __attribute__((ext_vector_type(2)));
__device__ __forceinline__ unsigned cvt_pk_bf16(float lo, float hi) { const cvf32x2_t v = {lo, hi}; const cvbf16x2_t b = __builtin_convertvector(v, cvbf16x2_t); return __builtin_bit_cast(unsigned, b); }
typedef unsigned u32x2 __attribute__((ext_vector_type(2)));
__device__ __forceinline__ float bf_lo(unsigned w) { return __uint_as_float(w << 16); }
__device__ __forceinline__ float bf_hi(unsigned w) { return __uint_as_float(w & 0xffff0000u); }
__device__ __forceinline__ float fsigmoid(float x) { return __builtin_amdgcn_rcpf(1.f + __expf(-x)); }
__device__ __forceinline__ u32x4 pack8(const f32x4 a, const f32x4 b) { u32x4 w; w.x = cvt_pk_bf16(a[0], a[1]); w.y = cvt_pk_bf16(a[2], a[3]); w.z = cvt_pk_bf16(b[0], b[1]); w.w = cvt_pk_bf16(b[2], b[3]); return w; }

struct EpiProj {
    static constexpr bool PERM = true, AFTER_DRAIN = false;
    __device__ __forceinline__ void init(f32x4 (&acc)[2][2][4][2], const Unit&, int, int, int, int) const {
#pragma unroll
        for (int a = 0; a < 2; ++a)
#pragma unroll
            for (int b = 0; b < 2; ++b)
#pragma unroll
                for (int m = 0; m < 4; ++m)
#pragma unroll
                    for (int n = 0; n < 2; ++n) acc[a][b][m][n] = (f32x4){0.f, 0.f, 0.f, 0.f};
    }
    bf16_t* base5;
    static constexpr size_t KSTRIDE = (size_t)18 * 1024 * 1024 / 2;
    const float *ropec, *ropes;
    const float* ss0;
    __device__ __forceinline__ void operator()(const f32x4 (&acc)[2][2][4][2], const Unit& u, int wr, int wc, int fr, int fq) const {
        const int kind = u.pn >> 2, sub = u.pn & 3;
        const int row0 = u.pm * BM + wr * 64 + fr;
        float srv[2][4];
#pragma unroll
        for (int ai = 0; ai < 2; ++ai)
#pragma unroll
            for (int m = 0; m < 4; ++m) srv[ai][m] = ss0[row0 + ai * HALF + m * 16];
        if (kind == 1 || kind == 2) {
            bf16_t* dst = base5 + (size_t)kind * KSTRIDE;
            const int head = 2 * sub + (wc >> 1), j0 = 32 * (wc & 1) + 8 * fq;
            const float l2g = __log2f(1.f - exp2f(-5.f - (float)head));
            const float ksc = (kind == 2) ? 0.08838834764831845f : 1.f;
#pragma unroll
            for (int ai = 0; ai < 2; ++ai)
#pragma unroll
                for (int m = 0; m < 4; ++m) {
                    const int r = row0 + ai * HALF + m * 16;
                    int pi; float sc;
                    if (r < 8192) { const int t = r & 2047; pi = t; const int tt = t & 127; sc = exp2f(l2g * (kind == 1 ? (float)(tt - 127) : (float)(127 - tt))) * ksc; }
                    else { pi = 2048 + (r & 7); sc = ksc; }
                    const f32x4 c0 = *(const f32x4*)(ropec + pi * 64 + j0), c1 = *(const f32x4*)(ropec + pi * 64 + j0 + 4);
                    const f32x4 s0 = *(const f32x4*)(ropes + pi * 64 + j0), s1 = *(const f32x4*)(ropes + pi * 64 + j0 + 4);
                    sc *= rsqrtf(srv[ai][m] * (1.f / 2048.f) + 1e-6f);
                    const f32x4 x1a = acc[ai][0][m][0], x1b = acc[ai][0][m][1], x2a = acc[ai][1][m][0], x2b = acc[ai][1][m][1];
                    const f32x4 r1a = (x1a * c0 - x2a * s0) * sc, r1b = (x1b * c1 - x2b * s1) * sc;
                    const f32x4 r2a = (x1a * s0 + x2a * c0) * sc, r2b = (x1b * s1 + x2b * c1) * sc;
                    bf16_t* rowp = dst + (size_t)r * 1024 + head * 128 + j0;
                    *(u32x4*)(rowp) = pack8(r1a, r1b);
                    *(u32x4*)(rowp + 64) = pack8(r2a, r2b);
                }
        } else {
            bf16_t* dst = base5 + (size_t)kind * KSTRIDE;
            const int col0 = 256 * sub + wc * 32 + 8 * fq;
#pragma unroll
            for (int ai = 0; ai < 2; ++ai)
#pragma unroll
                for (int m = 0; m < 4; ++m) {
                    bf16_t* rowp = dst + (size_t)(row0 + ai * HALF + m * 16) * 1024 + col0;
                    const float sr = rsqrtf(srv[ai][m] * (1.f / 2048.f) + 1e-6f);
#pragma unroll
                    for (int bj = 0; bj < 2; ++bj) {
                        f32x4 v0 = acc[ai][bj][m][0] * sr, v1 = acc[ai][bj][m][1] * sr;
                        if (kind == 4) {
#pragma unroll
                            for (int i = 0; i < 4; ++i) { v0[i] = v0[i] * fsigmoid(v0[i]); v1[i] = v1[i] * fsigmoid(v1[i]); }
                        }
                        *(u32x4*)(rowp + bj * HALF) = pack8(v0, v1);
                    }
                }
        }
    }
};

struct EpiGlu {
    static constexpr bool PERM = true, AFTER_DRAIN = false;
    __device__ __forceinline__ void init(f32x4 (&acc)[2][2][4][2], const Unit&, int, int, int, int) const {
#pragma unroll
        for (int a = 0; a < 2; ++a)
#pragma unroll
            for (int b = 0; b < 2; ++b)
#pragma unroll
                for (int m = 0; m < 4; ++m)
#pragma unroll
                    for (int n = 0; n < 2; ++n) acc[a][b][m][n] = (f32x4){0.f, 0.f, 0.f, 0.f};
    }
    const bf16_t* Y; bf16_t* O; const float* bias;
    __device__ __forceinline__ void operator()(const f32x4 (&acc)[2][2][4][2], const Unit& u, int wr, int wc, int fr, int fq) const {
        const int row0 = u.pm * BM + wr * 64 + fr, col0 = u.pn * BM + wc * 32 + 8 * fq;
        f32x4 bv[2][2];
#pragma unroll
        for (int bj = 0; bj < 2; ++bj)
#pragma unroll
            for (int n = 0; n < 2; ++n) bv[bj][n] = *(const f32x4*)(bias + col0 + bj * HALF + 4 * n);
#pragma unroll
        for (int ai = 0; ai < 2; ++ai)
#pragma unroll
            for (int m = 0; m < 4; ++m) {
                const size_t r = (size_t)(row0 + ai * HALF + m * 16);
#pragma unroll
                for (int bj = 0; bj < 2; ++bj) {
                    const u32x4 yw = *(const u32x4*)(Y + r * 1024 + col0 + bj * HALF);
                    const f32x4 z0 = acc[ai][bj][m][0] + bv[bj][0], z1 = acc[ai][bj][m][1] + bv[bj][1];
                    f32x4 o0, o1;
                    o0[0] = bf_lo(yw.x) * fsigmoid(z0[0]); o0[1] = bf_hi(yw.x) * fsigmoid(z0[1]); o0[2] = bf_lo(yw.y) * fsigmoid(z0[2]); o0[3] = bf_hi(yw.y) * fsigmoid(z0[3]);
                    o1[0] = bf_lo(yw.z) * fsigmoid(z1[0]); o1[1] = bf_hi(yw.z) * fsigmoid(z1[1]); o1[2] = bf_lo(yw.w) * fsigmoid(z1[2]); o1[3] = bf_hi(yw.w) * fsigmoid(z1[3]);
                    *(u32x4*)(O + r * 2048 + col0 + bj * HALF) = pack8(o0, o1);
                }
            }
    }
};

struct EpiSwiglu {
    static constexpr bool PERM = true, AFTER_DRAIN = false;
    __device__ __forceinline__ void init(f32x4 (&acc)[2][2][4][2], const Unit&, int, int, int, int) const {
#pragma unroll
        for (int a = 0; a < 2; ++a)
#pragma unroll
            for (int b = 0; b < 2; ++b)
#pragma unroll
                for (int m = 0; m < 4; ++m)
#pragma unroll
                    for (int n = 0; n < 2; ++n) acc[a][b][m][n] = (f32x4){0.f, 0.f, 0.f, 0.f};
    }
    bf16_t* O; int ldo; const float* ss;
    __device__ __forceinline__ void operator()(const f32x4 (&acc)[2][2][4][2], const Unit& u, int wr, int wc, int fr, int fq) const {
        const int row0 = u.pm * BM + u.roff + wr * 64 + fr, col0 = u.pn * HALF + wc * 32 + 8 * fq;
        float srv[2][4];
#pragma unroll
        for (int ai = 0; ai < 2; ++ai)
#pragma unroll
            for (int m = 0; m < 4; ++m) srv[ai][m] = (ai == 1 && u.hm) ? 1.f : ss[row0 + ai * HALF + m * 16];
#pragma unroll
        for (int ai = 0; ai < 2; ++ai)
#pragma unroll
            for (int m = 0; m < 4; ++m) {
                if (ai == 1 && u.hm) continue;
                const float sr = rsqrtf(srv[ai][m] * (1.f / 2048.f) + 1e-6f);
                const f32x4 g0 = acc[ai][0][m][0] * sr, g1 = acc[ai][0][m][1] * sr, u0 = acc[ai][1][m][0] * sr, u1 = acc[ai][1][m][1] * sr;
                f32x4 a0, a1;
#pragma unroll
                for (int i = 0; i < 4; ++i) { a0[i] = g0[i] * fsigmoid(g0[i]) * u0[i]; a1[i] = g1[i] * fsigmoid(g1[i]) * u1[i]; }
                *(u32x4*)(O + (size_t)(row0 + ai * HALF + m * 16) * ldo + col0) = pack8(a0, a1);
            }
    }
};

template <int MODE> struct EpiResid {
    static constexpr bool PERM = true, AFTER_DRAIN = false;
    bf16_t* xb; bf16_t* slab; float* ss;
    __device__ __forceinline__ void init(f32x4 (&acc)[2][2][4][2], const Unit& u, int wr, int wc, int fr, int fq) const {
        const int row0 = u.pm * BM + wr * 64 + fr, col0 = u.pn * BM + wc * 32 + 8 * fq;
#pragma unroll
        for (int ai = 0; ai < 2; ++ai)
#pragma unroll
            for (int m = 0; m < 4; ++m) {
                const bf16_t* xr = xb + (size_t)(row0 + ai * HALF + m * 16) * 2048 + col0;
#pragma unroll
                for (int bj = 0; bj < 2; ++bj) {
                    if (u.sp >= 0) { acc[ai][bj][m][0] = (f32x4){0.f, 0.f, 0.f, 0.f}; acc[ai][bj][m][1] = (f32x4){0.f, 0.f, 0.f, 0.f}; }
                    else { const u32x4 w = *(const u32x4*)(xr + bj * HALF);
                        acc[ai][bj][m][0] = (f32x4){bf_lo(w.x), bf_hi(w.x), bf_lo(w.y), bf_hi(w.y)}; acc[ai][bj][m][1] = (f32x4){bf_lo(w.z), bf_hi(w.z), bf_lo(w.w), bf_hi(w.w)}; }
                }
            }
    }
    __device__ __forceinline__ void operator()(const f32x4 (&acc)[2][2][4][2], const Unit& u, int wr, int wc, int fr, int fq) const {
        const int row0 = u.pm * BM + wr * 64 + fr, col0 = u.pn * BM + wc * 32 + 8 * fq;
        if (u.sp >= 0) {
            bf16_t* sb = slab + ((size_t)u.sp * 1024 + (size_t)(row0 - 8192)) * 2048 + col0;
#pragma unroll
            for (int ai = 0; ai < 2; ++ai)
#pragma unroll
                for (int m = 0; m < 4; ++m)
#pragma unroll
                    for (int bj = 0; bj < 2; ++bj) *(u32x4*)(sb + (size_t)(ai * HALF + m * 16) * 2048 + bj * HALF) = pack8(acc[ai][bj][m][0], acc[ai][bj][m][1]);
            return;
        }
#pragma unroll
        for (int ai = 0; ai < 2; ++ai)
#pragma unroll
            for (int m = 0; m < 4; ++m) {
                const int r = row0 + ai * HALF + m * 16;
                bf16_t* xr = xb + (size_t)r * 2048 + col0;
                float q = 0.f;
#pragma unroll
                for (int bj = 0; bj < 2; ++bj) { const f32x4 v0 = acc[ai][bj][m][0], v1 = acc[ai][bj][m][1];
                    q += ((v0[0] * v0[0] + v0[1] * v0[1]) + (v0[2] * v0[2] + v0[3] * v0[3])) + ((v1[0] * v1[0] + v1[1] * v1[1]) + (v1[2] * v1[2] + v1[3] * v1[3]));
                    *(u32x4*)(xr + bj * HALF) = pack8(v0, v1); }
                if (MODE == 0) { q += __shfl_xor(q, 16); q += __shfl_xor(q, 32); if (fq == 0) atomicAdd(ss + r, q); }
            }
    }
};

template <class Epi, class Sched, bool ALIGN_EPI = false, bool SP2 = false>
__device__ __forceinline__ void gemm_phase(PG8_LAS unsigned char* lds, const Gemm g, const Sched& S, const Epi& E) {
    const int tid = threadIdx.x, wid = __builtin_amdgcn_readfirstlane(tid >> 6), lane = tid & 63, wr = wid >> 2, wc = wid & 3, fr = lane & 15, fq = lane >> 4;
    const int K = g.K;
    unsigned voffA[2], voffB[2];
#pragma unroll
    for (int i = 0; i < 2; ++i) { int R, C; stage_rc(tid * 16 + i * 8192, R, C); const int Rb = Epi::PERM ? ((R & ~31) + perm32(R & 31)) : R;
        voffA[i] = (unsigned)(R * K + C) * 2u; voffB[i] = (unsigned)(Rb * K + C) * 2u; }
    const size_t kstep = (size_t)(BK * 2);
    const size_t hstep = (size_t)HALF * K * 2;
    const size_t tstep = 2 * hstep;
    const unsigned ldsw = (unsigned)wid * 1024u;
    const int aoff = lds_byte(wr * 64 + fr, fq * 8), boff = lds_byte(wc * 32 + fr, fq * 8);
#define PG8_SA(b, h) (((b) * 2 + (h)) * HTB)
#define PG8_SB(b, h) ((4 + (b) * 2 + (h)) * HTB)
#define PG8_STAGE(bufoff, gbase, voff) do { _Pragma("unroll") for (int _i = 0; _i < 2; ++_i) \
        __builtin_amdgcn_global_load_lds((const unsigned*)((const char*)(gbase) + (voff)[_i]), (PG8_LAS unsigned*)(lds + (bufoff) + ldsw + _i * 8192), 16, 0, 0); } while (0)
#define PG8_LDA(dst, b, h) do { _Pragma("unroll") for (int m = 0; m < 4; ++m) _Pragma("unroll") for (int k = 0; k < 2; ++k) dst[m][k] = *(const PG8_LAS bf16x8*)(lds + PG8_SA(b, h) + aoff + m * 2048 + k * 1024); } while (0)
#define PG8_LDB(dst, b, h) do { _Pragma("unroll") for (int n = 0; n < 2; ++n) _Pragma("unroll") for (int k = 0; k < 2; ++k) dst[n][k] = *(const PG8_LAS bf16x8*)(lds + PG8_SB(b, h) + boff + n * 2048 + k * 1024); } while (0)
#define PG8_MMA(ai, bj, At, Bt) do { __builtin_amdgcn_s_setprio(1); _Pragma("unroll") for (int m = 0; m < 4; ++m) _Pragma("unroll") for (int n = 0; n < 2; ++n) _Pragma("unroll") for (int k = 0; k < 2; ++k) \
        acc[ai][bj][m][n] = __builtin_amdgcn_mfma_f32_16x16x32_bf16(Bt[n][k], At[m][k], acc[ai][bj][m][n], 0, 0, 0); __builtin_amdgcn_s_setprio(0); } while (0)
#define PG8_WAIT_V(n) asm volatile("s_waitcnt vmcnt(" #n ")" ::: "memory")
#define PG8_WAIT_L(n) asm volatile("s_waitcnt lgkmcnt(" #n ")" ::: "memory")
#define PG8_BAR __builtin_amdgcn_s_barrier()
#define PG8_SCHED __builtin_amdgcn_sched_barrier(0)
    Unit cur, nxt; int ui = 0;
    if (!S.next(0, cur)) return;
    f32x4 acc[2][2][4][2];
    E.init(acc, cur, wr, wc, fr, fq);
    bf16x8 At[4][2], B0[2][2], B1[2][2];
    const char* cA = (const char*)g.A + (size_t)cur.pm * tstep + (size_t)cur.kt0 * kstep + (size_t)cur.roff * K * 2; const char* cB = (const char*)g.Bt + (size_t)cur.pn * tstep + (size_t)cur.kt0 * kstep;
    S.a_ready(cur);
    if constexpr (SP2) {
        PG8_STAGE(PG8_SB(0, 0), cB, voffB); PG8_STAGE(PG8_SB(0, 1), cB + hstep, voffB); PG8_STAGE(PG8_SA(0, 0), cA, voffA); PG8_STAGE(PG8_SA(0, 1), cA + hstep, voffA);
        if (wr == 1) PG8_BAR;
        PG8_WAIT_V(2); PG8_BAR;
        PG8_STAGE(PG8_SB(1, 0), cB + kstep, voffB); PG8_STAGE(PG8_SA(1, 0), cA + kstep, voffA); PG8_STAGE(PG8_SB(1, 1), cB + hstep + kstep, voffB);
        PG8_WAIT_V(6); PG8_BAR;
    } else {
        PG8_STAGE(PG8_SB(0, 0), cB, voffB); PG8_STAGE(PG8_SA(0, 0), cA, voffA); PG8_STAGE(PG8_SB(0, 1), cB + hstep, voffB); PG8_STAGE(PG8_SA(0, 1), cA + hstep, voffA);
        if (wr == 1) PG8_BAR;
        PG8_WAIT_V(4); PG8_BAR;
        PG8_STAGE(PG8_SB(1, 0), cB + kstep, voffB); PG8_STAGE(PG8_SA(1, 0), cA + kstep, voffA); PG8_STAGE(PG8_SB(1, 1), cB + hstep + kstep, voffB);
        PG8_WAIT_V(6); PG8_BAR;
    }
    for (;;) {
        const bool has_next = S.next(ui + 1, nxt);
        const char* nA = has_next ? (const char*)g.A + (size_t)nxt.pm * tstep + (size_t)nxt.kt0 * kstep + (size_t)nxt.roff * K * 2 : cA; const char* nB = has_next ? (const char*)g.Bt + (size_t)nxt.pn * tstep + (size_t)nxt.kt0 * kstep : cB;
        const int nt = cur.nt; const bool full = (cur.hm == 0);
        for (int t = 0; t < nt; t += 2) {
            const bool last = (t == nt - 2);
            const char* a1 = cA + (size_t)(t + 1) * kstep;
            const char* a2 = last ? nA : cA + (size_t)(t + 2) * kstep; const char* b2 = last ? nB : cB + (size_t)(t + 2) * kstep;
            const char* a3 = a2 + kstep; const char* b3 = b2 + kstep;
            if (last && has_next) S.a_ready(nxt);
            if constexpr (SP2) {
            PG8_LDB(B0, 0, 0); PG8_LDB(B1, 0, 1); PG8_SCHED; PG8_LDA(At, 0, 0); PG8_STAGE(PG8_SA(1, 1), a1 + hstep, voffA);
            PG8_WAIT_V(8); PG8_WAIT_L(0); PG8_BAR; PG8_MMA(0, 0, At, B0); PG8_MMA(0, 1, At, B1); PG8_BAR; PG8_SCHED;
            if (full) PG8_LDA(At, 0, 1); PG8_STAGE(PG8_SB(0, 0), b2, voffB); PG8_STAGE(PG8_SB(0, 1), b2 + hstep, voffB); PG8_STAGE(PG8_SA(0, 0), a2, voffA);
            PG8_WAIT_V(8); PG8_WAIT_L(0); PG8_BAR; if (full) { PG8_MMA(1, 0, At, B0); PG8_MMA(1, 1, At, B1); } PG8_BAR; PG8_SCHED;
            PG8_LDB(B0, 1, 0); PG8_LDB(B1, 1, 1); PG8_SCHED; PG8_LDA(At, 1, 0); PG8_STAGE(PG8_SA(0, 1), a2 + hstep, voffA);
            PG8_WAIT_V(8); PG8_WAIT_L(0); PG8_BAR; PG8_MMA(0, 0, At, B0); PG8_MMA(0, 1, At, B1); PG8_BAR; PG8_SCHED;
            if (full) PG8_LDA(At, 1, 1); PG8_STAGE(PG8_SB(1, 0), b3, voffB); PG8_STAGE(PG8_SB(1, 1), b3 + hstep, voffB); PG8_STAGE(PG8_SA(1, 0), a3, voffA);
            PG8_WAIT_V(8); PG8_WAIT_L(0); PG8_BAR; if (full) { PG8_MMA(1, 0, At, B0); PG8_MMA(1, 1, At, B1); } PG8_BAR; PG8_SCHED;
            } else {
            PG8_LDB(B0, 0, 0); PG8_SCHED; PG8_LDA(At, 0, 0); PG8_STAGE(PG8_SA(1, 1), a1 + hstep, voffA);
            PG8_WAIT_L(8); PG8_BAR; PG8_WAIT_L(0); PG8_MMA(0, 0, At, B0); PG8_BAR; PG8_SCHED;
            PG8_LDB(B1, 0, 1); PG8_STAGE(PG8_SB(0, 0), b2, voffB);
            PG8_BAR; PG8_WAIT_L(0); PG8_MMA(0, 1, At, B1); PG8_BAR;
            PG8_LDA(At, 0, 1); PG8_STAGE(PG8_SA(0, 0), a2, voffA);
            PG8_BAR; PG8_WAIT_L(0); PG8_MMA(1, 0, At, B0); PG8_BAR; PG8_SCHED;
            PG8_STAGE(PG8_SB(0, 1), b2 + hstep, voffB);
            PG8_WAIT_V(6); PG8_BAR; PG8_MMA(1, 1, At, B1); PG8_BAR;
            PG8_LDB(B0, 1, 0); PG8_SCHED; PG8_LDA(At, 1, 0); PG8_STAGE(PG8_SA(0, 1), a2 + hstep, voffA);
            PG8_WAIT_L(8); PG8_BAR; PG8_WAIT_L(0); PG8_MMA(0, 0, At, B0); PG8_BAR; PG8_SCHED;
            PG8_LDB(B1, 1, 1); PG8_STAGE(PG8_SB(1, 0), b3, voffB);
            PG8_BAR; PG8_WAIT_L(0); PG8_MMA(0, 1, At, B1); PG8_BAR;
            PG8_LDA(At, 1, 1); PG8_STAGE(PG8_SA(1, 0), a3, voffA);
            PG8_BAR; PG8_WAIT_L(0); PG8_MMA(1, 0, At, B0); PG8_BAR; PG8_SCHED;
            PG8_STAGE(PG8_SB(1, 1), b3 + hstep, voffB);
            PG8_WAIT_V(6); PG8_BAR; PG8_MMA(1, 1, At, B1); PG8_BAR;
            }
        }
        if constexpr (ALIGN_EPI) { if (wr == 0) PG8_BAR; }
        if constexpr (!Epi::AFTER_DRAIN) { E(acc, cur, wr, wc, fr, fq); S.done(cur); }
        if (!has_next) break;
        E.init(acc, nxt, wr, wc, fr, fq);
        cur = nxt; cA = nA; cB = nB; ++ui;
        if constexpr (ALIGN_EPI) { if (wr == 1) PG8_BAR; }
    }
    PG8_WAIT_V(0);
    if constexpr (!ALIGN_EPI) { if (wr == 0) PG8_BAR; }
    PG8_BAR;
    if constexpr (Epi::AFTER_DRAIN) { E.fused(acc, cur, wr, wc, fr, fq, lds, wid, lane); S.done(cur); }
#undef PG8_SA
#undef PG8_SB
#undef PG8_STAGE
#undef PG8_LDA
#undef PG8_LDB
#undef PG8_MMA
#undef PG8_WAIT_V
#undef PG8_WAIT_L
#undef PG8_BAR
#undef PG8_SCHED
}
}
#define GAS __attribute__((address_space(1)))
#define LAS __attribute__((address_space(3)))
typedef unsigned short bf16;
typedef unsigned v4u __attribute__((ext_vector_type(4)));
typedef float f32x4 __attribute__((ext_vector_type(4)));
typedef short bf16x8 __attribute__((ext_vector_type(8)));
typedef GAS unsigned gu32;
typedef GAS unsigned long long gu64;
#define RLX_AGENT __ATOMIC_RELAXED, __HIP_MEMORY_SCOPE_AGENT
#define LDS_WAIT() asm volatile("s_waitcnt lgkmcnt(0)" ::: "memory")
#define VM_WAIT() asm volatile("s_waitcnt vmcnt(0)" ::: "memory")
__device__ __forceinline__ unsigned long long rt() { return __builtin_amdgcn_s_memrealtime(); }
__device__ __forceinline__ unsigned f2bf(float f) { unsigned u = __builtin_bit_cast(unsigned, f); return (u + 0x7fffu + ((u >> 16) & 1u)) >> 16; }
__device__ __forceinline__ unsigned pk2(float lo, float hi) { return f2bf(lo) | (f2bf(hi) << 16); }

#define XB_TMO      128
#define XB_XCNT(j)  (256  + 64 * (j))
#define XB_XSUB(j)  (1280 + 64 * (j))
#define XB_XGEN(j)  (2304 + 64 * (j))
#define XB_TOP      3328
#define XB_TOPGEN   3392
#define XCD_BAR_WORDS 3456
#define XB_SPIN_CAP (1u << 18)

__device__ __forceinline__ unsigned xb_ld(unsigned* p)              { return __hip_atomic_load(p, __ATOMIC_RELAXED, __HIP_MEMORY_SCOPE_AGENT); }
__device__ __forceinline__ unsigned xb_add(unsigned* p, unsigned v) { return __hip_atomic_fetch_add(p, v, __ATOMIC_RELAXED, __HIP_MEMORY_SCOPE_AGENT); }
__device__ __forceinline__ unsigned xb_xcc_id() { return (unsigned)__builtin_amdgcn_s_getreg((3 << 11) | 20) & 0xFu; }
#define XB_SPIN(cond, bar) do { unsigned _sp = 0; while (cond) { __builtin_amdgcn_s_sleep(1); \
    if ((++_sp & 255u) == 0u) { if (xb_ld(&(bar)[XB_TMO])) break; if (_sp > XB_SPIN_CAP) { atomicAdd(&(bar)[XB_TMO], 1u); break; } } } } while (0)

struct XcdBarrier {
    unsigned* bar; unsigned x;
    volatile LAS unsigned* st;
};

__device__ __forceinline__ XcdBarrier xcd_barrier_post(unsigned* bar, volatile LAS unsigned* st) {
    XcdBarrier b; b.bar = bar; b.x = xb_xcc_id(); b.st = st;
    if (threadIdx.x == 0) (void)xb_add(&bar[XB_XCNT(b.x)], 1u);
    return b;
}
__device__ __forceinline__ void xcd_barrier_complete(unsigned* bar, unsigned x, unsigned& nloc, unsigned& nx) {
    const unsigned G = gridDim.x * gridDim.y * gridDim.z;
    unsigned sum, cnt, mine, sp = 0u;
    for (;;) {
        sum = 0u; cnt = 0u; mine = 0u;
#pragma unroll
        for (unsigned j = 0; j < 16; ++j) { const unsigned c = xb_ld(&bar[XB_XCNT(j)]); sum += c; cnt += (c > 0u) ? 1u : 0u; mine = (j == x) ? c : mine; }
        if (sum == G) break;
        __builtin_amdgcn_s_sleep(1);
        if ((++sp & 255u) == 0u) { if (xb_ld(&bar[XB_TMO])) break; if (sp > XB_SPIN_CAP) { atomicAdd(&bar[XB_TMO], 1u); break; } }
    }
    nloc = mine > 0u ? mine : 1u; nx = cnt > 0u ? cnt : 1u;
}

__device__ __forceinline__ void xcd_barrier(const XcdBarrier& b) {
    asm volatile("s_waitcnt vmcnt(0)" ::: "memory");
    __syncthreads();
    if (threadIdx.x == 0) {
        unsigned* bar = b.bar;
        __builtin_amdgcn_s_waitcnt(0);
        unsigned nloc = b.st[0], nx = b.st[1];
        if (nloc == 0u) { xcd_barrier_complete(bar, b.x, nloc, nx); b.st[0] = nloc; b.st[1] = nx; }
        const unsigned old = xb_add(&bar[XB_XSUB(b.x)], 1u);
        const unsigned gen = old / nloc;
        if (old + 1u == (gen + 1u) * nloc) {
            __builtin_amdgcn_fence(__ATOMIC_RELEASE, "agent");
            asm volatile("s_waitcnt vmcnt(0)" ::: "memory");
            const unsigned og = xb_add(&bar[XB_TOP], 1u);
            const unsigned tg = og / nx;
            if (og + 1u == (tg + 1u) * nx) xb_add(&bar[XB_TOPGEN], 1u);
            else XB_SPIN(xb_ld(&bar[XB_TOPGEN]) == tg, bar);
            __builtin_amdgcn_fence(__ATOMIC_ACQUIRE, "agent");
            xb_add(&bar[XB_XGEN(b.x)], 1u);
            asm volatile("s_waitcnt vmcnt(0)" ::: "memory");
        } else {
            XB_SPIN(xb_ld(&bar[XB_XGEN(b.x)]) == gen, bar);
            __builtin_amdgcn_fence(__ATOMIC_ACQUIRE, "agent");
            asm volatile("s_waitcnt vmcnt(0)" ::: "memory");
        }
    }
    __syncthreads();
}

typedef short s16x4 __attribute__((ext_vector_type(4)));
typedef float f32x2v __attribute__((ext_vector_type(2)));
typedef float f32x16 __attribute__((ext_vector_type(16)));
typedef unsigned u32x2v __attribute__((ext_vector_type(2)));

struct Frame {
    LAS unsigned char* lds;
    volatile LAS unsigned* MISC;
    gu32* ctl;
    int tid, lane, wave;
    int G;
    const float *x_prompt, *x_sample, *st_re, *st_im, *st_ret, *norm_mix, *w_in, *lam_re, *lam_im, *log_step, *b_re, *b_im, *c_re, *c_im, *s5_d, *w_glu, *b_glu, *gn_w, *w_out, *norm_ffn, *w_ffn_in, *w_ffn_out, *norm_final;
    float *Y, *o_s5re_p, *o_s5im_p, *o_ret_p, *o_s5re_s, *o_s5im_s, *o_ret_s;
    float *LBR, *LBI, *ROPEC, *ROPES, *SS0;
    bf16 *BB, *CMT;
    bf16 *WIN_T, *WGLU_T, *WOUT_T, *WFI_T, *WFO_T;
    bf16 *XN, *U, *Q, *Kb, *V, *Gt, *Ob, *YS5, *MIX, *ACT;
    bf16 *S5Lm, *S5Hm, *S5Gm;
};

__device__ __forceinline__ float wave_sum(float v) {
#pragma unroll
    for (int o = 1; o < 64; o <<= 1) v += __shfl_xor(v, o);
    return v;
}
__device__ __forceinline__ unsigned offb(unsigned row, unsigned ch) { return 256u * row + 16u * (ch ^ (((row & 3u) << 2) | ((row >> 2) & 3u))); }
typedef float cvf32x2 __attribute__((ext_vector_type(2))); typedef __bf16 cvbf16x2 __attribute__((ext_vector_type(2)));
__device__ __forceinline__ unsigned cvtpk(float lo, float hi) { const cvf32x2 v = {lo, hi}; const cvbf16x2 b = __builtin_convertvector(v, cvbf16x2); return __builtin_bit_cast(unsigned, b); }
__device__ __forceinline__ float bflo(unsigned w) { return __uint_as_float(w << 16); }
__device__ __forceinline__ float bfhi(unsigned w) { return __uint_as_float(w & 0xffff0000u); }
__device__ __forceinline__ bf16x8 tr_pair(LAS unsigned char* base, unsigned a0, unsigned a1) {
    const s16x4 lo = __builtin_amdgcn_ds_read_tr16_b64_v4i16((LAS s16x4*)(base + a0));
    const s16x4 hi = __builtin_amdgcn_ds_read_tr16_b64_v4i16((LAS s16x4*)(base + a1));
    return __builtin_shufflevector(lo, hi, 0, 1, 2, 3, 4, 5, 6, 7);
}

#define LDS_BARRIER() do { asm volatile("s_waitcnt lgkmcnt(0)" ::: "memory"); __builtin_amdgcn_s_barrier(); asm volatile("" ::: "memory"); } while (0)
template <int K, int N> __device__ __forceinline__ void p0_ld(const float* W, int kb, int nb, float (&r)[32], int lane, const float* kscale = nullptr) {
#pragma unroll
    for (int i = 0; i < 32; ++i) r[i] = __builtin_nontemporal_load(W + (size_t)(64 * kb + 2 * i + (lane >> 5)) * N + 32 * nb + (lane & 31));
    if (kscale) {
#pragma unroll
        for (int i = 0; i < 32; ++i) r[i] *= kscale[64 * kb + 2 * i + (lane >> 5)];
    }
}
template <int K> __device__ __forceinline__ void p0_st(bf16* WT, int kb, int drow0, const float (&r)[32], LAS float* scr, int lane) {
#pragma unroll
    for (int i = 0; i < 32; ++i) scr[(2 * i + (lane >> 5)) * 33 + (lane & 31)] = r[i];
    LDS_WAIT(); asm volatile("" ::: "memory");
    const int c = lane & 7;
#pragma unroll
    for (int j = 0; j < 4; ++j) { const int n = (lane >> 3) + 8 * j; const LAS float* s = scr + (8 * c) * 33 + n;
        v4u o; o.x = pk2(s[0 * 33], s[1 * 33]); o.y = pk2(s[2 * 33], s[3 * 33]); o.z = pk2(s[4 * 33], s[5 * 33]); o.w = pk2(s[6 * 33], s[7 * 33]);
        *(GAS v4u*)(WT + (size_t)(drow0 + n) * K + 64 * kb + 8 * c) = o; }
    LDS_WAIT(); asm volatile("" ::: "memory");
}
__device__ __forceinline__ int win_dest_row(int n0) {
    if (n0 < 1024 || n0 >= 3072) return n0;
    const int kind = n0 >> 10, rel = n0 & 1023, head = rel >> 7, bj = (rel >> 6) & 1, j = rel & 63;
    return 1024 * kind + 256 * (head >> 1) + 128 * bj + 64 * (head & 1) + j;
}
__device__ __forceinline__ int wfi_dest_row(int n0) {
    const int up = n0 >= 5632 ? 1 : 0, cc = n0 - up * 5632;
    return 256 * (cc >> 7) + 128 * up + (cc & 127);
}
__device__ __forceinline__ void rms_row_load(const float* xrow, f32x4 (&v)[8], int lane) {
    const GAS f32x4* xr = (const GAS f32x4*)xrow + lane;
#pragma unroll
    for (int j = 0; j < 8; ++j) v[j] = __builtin_nontemporal_load(xr + 64 * j);
}
__device__ __forceinline__ void rms_row_finish(const f32x4 (&v)[8], float* ssrow, bf16* orow, int lane) {
    float s = 0.f;
#pragma unroll
    for (int j = 0; j < 8; ++j) s += (v[j].x * v[j].x + v[j].y * v[j].y) + (v[j].z * v[j].z + v[j].w * v[j].w);
    s = wave_sum(s);
    if (lane == 0) *ssrow = s;
    GAS unsigned long long* o8 = (GAS unsigned long long*)orow + lane;
#pragma unroll
    for (int j = 0; j < 8; ++j) o8[64 * j] = (unsigned long long)pk2(v[j].x, v[j].y) | ((unsigned long long)pk2(v[j].z, v[j].w) << 32);
}
__device__ __forceinline__ const float* xrow_ptr(const Frame& F, int r) { return r < 8192 ? F.x_prompt + (size_t)r * 2048 : F.x_sample + (size_t)(r - 8192) * 2048; }

constexpr int I_IN = 32 * 160, I_GLU = 16 * 32, I_OUT = 32 * 64, I_FI = 32 * 352, I_FO = 88 * 64, NITEMS = I_IN + I_GLU + I_OUT + I_FI + I_FO;
constexpr int I_FO_P0 = 1792;
__device__ __forceinline__ void p0_item_load(const Frame& F, int it, float (&r)[32], int lane) {
    int q = it;
    if (q < I_IN)  { p0_ld<2048, 5120>(F.w_in, q / 160, q % 160, r, lane, F.norm_mix); return; } q -= I_IN;
    if (q < I_GLU) { p0_ld<1024, 1024>(F.w_glu, q / 32, q % 32, r, lane); return; } q -= I_GLU;
    if (q < I_OUT) { p0_ld<2048, 2048>(F.w_out, q / 64, q % 64, r, lane); return; } q -= I_OUT;
    if (q < I_FI)  { p0_ld<2048, 11264>(F.w_ffn_in, q / 352, q % 352, r, lane, F.norm_ffn); return; } q -= I_FI;
    p0_ld<5632, 2048>(F.w_ffn_out, q / 64, q % 64, r, lane);
}
__device__ __forceinline__ void p0_item_store(const Frame& F, int it, const float (&r)[32], LAS float* scr, int lane) {
    int q = it;
    if (q < I_IN)  { p0_st<2048>(F.WIN_T, q / 160, win_dest_row(32 * (q % 160)), r, scr, lane); return; } q -= I_IN;
    if (q < I_GLU) { p0_st<1024>(F.WGLU_T, q / 32, 32 * (q % 32), r, scr, lane); return; } q -= I_GLU;
    if (q < I_OUT) { p0_st<2048>(F.WOUT_T, q / 64, 32 * (q % 64), r, scr, lane); return; } q -= I_OUT;
    if (q < I_FI)  { p0_st<2048>(F.WFI_T, q / 352, wfi_dest_row(32 * (q % 352)), r, scr, lane); return; } q -= I_FI;
    p0_st<5632>(F.WFO_T, q / 64, 32 * (q % 64), r, scr, lane);
}
__device__ __forceinline__ void p0_convert_items(const Frame& F, int first, int last, int gw, int NGW, LAS float* scr) {
    float ra[32], rb[32];
    int it = first + gw;
    if (it < last) p0_item_load(F, it, ra, F.lane);
    for (; it < last; it += 2 * NGW) {
        const bool hb = it + NGW < last, ha = it + 2 * NGW < last;
        if (hb) p0_item_load(F, it + NGW, rb, F.lane);
        p0_item_store(F, it, ra, scr, F.lane);
        if (ha) p0_item_load(F, it + 2 * NGW, ra, F.lane);
        if (hb) p0_item_store(F, it + NGW, rb, scr, F.lane);
    }
}
__device__ __forceinline__ void s5_lambar(const Frame& F, int i  , float& cr, float& ci, double& fr, double& fi) {
    const float dt = (float)exp((double)F.log_step[i >> 6]);
    const float lr = F.lam_re[i], li = F.lam_im[i];
    const float are = __fmul_rn(lr, dt), aim = __fmul_rn(li, dt);
    const float er = (float)exp((double)are), cs = (float)cos((double)aim), sn = (float)sin((double)aim);
    cr = __fmul_rn(er, cs); ci = __fmul_rn(er, sn);
    const double nr = (double)cr - 1.0, ni = (double)ci, den = (double)lr * lr + (double)li * li;
    fr = (nr * lr + ni * li) / den; fi = (ni * lr - nr * li) / den;
}
__device__ __forceinline__ void s5_precompute(Frame& F, const int g) {
    LAS float* PW = (LAS float*)F.lds;
    LAS float* BBL = PW + 17 * 64 * 2;
    LAS float* KT = BBL + 64 * 16 * 2;
    LAS float* CL = KT + 4096;
    const int tid = F.tid, lane = F.lane, w = F.wave;
#pragma unroll
    for (int i = 0; i < 2; ++i) { const int q = tid + 512 * i; CL[2 * q] = F.c_re[g * 1024 + q]; CL[2 * q + 1] = F.c_im[g * 1024 + q]; }
    if (tid < 64) {
        const int p = tid; const float cr = F.LBR[g * 64 + p], ci = F.LBI[g * 64 + p];
        const double lr = F.lam_re[g * 64 + p], li = F.lam_im[g * 64 + p];
        const double nr = (double)cr - 1.0, ni = (double)ci, den = lr * lr + li * li;
        const double fr = (nr * lr + ni * li) / den, fi = (ni * lr - nr * li) / den;
        float ar = 1.f, ai = 0.f;
        for (int t = 0; t < 17; ++t) { PW[(t * 64 + p) * 2] = ar; PW[(t * 64 + p) * 2 + 1] = ai; const float nr2 = ar * cr - ai * ci, ni2 = ar * ci + ai * cr; ar = nr2; ai = ni2; }
        for (int h = 0; h < 16; ++h) { const double br = F.b_re[(g * 64 + p) * 16 + h], bi = F.b_im[(g * 64 + p) * 16 + h];
            BBL[(p * 16 + h) * 2] = (float)(fr * br - fi * bi); BBL[(p * 16 + h) * 2 + 1] = (float)(fr * bi + fi * br); }
    }
    __syncthreads();
    {
        float c_r[16], c_i[16], b_r[16], b_i[16];
#pragma unroll
        for (int ks = 0; ks < 16; ++ks) { const int p = 4 * ks + (lane >> 4);
            c_r[ks] = CL[(((lane & 15)) * 64 + p) * 2]; c_i[ks] = CL[(((lane & 15)) * 64 + p) * 2 + 1];
            b_r[ks] = BBL[(p * 16 + (lane & 15)) * 2]; b_i[ks] = BBL[(p * 16 + (lane & 15)) * 2 + 1]; }
#pragma unroll
        for (int tt = 0; tt < 2; ++tt) { const int tau = 2 * w + tt;
            f32x4 acc = {0.f, 0.f, 0.f, 0.f};
#pragma unroll
            for (int ks = 0; ks < 16; ++ks) { const int p = 4 * ks + (lane >> 4);
                const float wr_ = PW[(tau * 64 + p) * 2], wi_ = PW[(tau * 64 + p) * 2 + 1];
                const float cwr = c_r[ks] * wr_ - c_i[ks] * wi_, cwi = c_r[ks] * wi_ + c_i[ks] * wr_;
                acc = __builtin_amdgcn_mfma_f32_16x16x4f32(cwr, b_r[ks], acc, 0, 0, 0);
                acc = __builtin_amdgcn_mfma_f32_16x16x4f32(-cwi, b_i[ks], acc, 0, 0, 0); }
#pragma unroll
            for (int e = 0; e < 4; ++e) KT[(tau << 8) | ((4 * (lane >> 4) + e) << 4) | (lane & 15)] = acc[e];
        }
    }
    __syncthreads();
#pragma unroll 1
    for (int q = 0; q < 4; ++q) {
    {
        const int r = 64 * q + (tid >> 3), t = r >> 4, h = r & 15, cb = tid & 7;
        bf16* dst = F.S5Lm + ((size_t)g * 256 + r) * 256 + 32 * cb;
#pragma unroll
        for (int k = 0; k < 4; ++k) { float v[8];
#pragma unroll
            for (int e = 0; e < 8; ++e) { const int col = 8 * k + e, s_ = 2 * cb + (col >> 4), hp = col & 15;
                float x = (s_ <= t) ? KT[((t - s_) << 8) | (h << 4) | hp] : 0.f; if (s_ == t && hp == h) x += F.s5_d[16 * g + h]; v[e] = x; }
            v4u o; o.x = pk2(v[0], v[1]); o.y = pk2(v[2], v[3]); o.z = pk2(v[4], v[5]); o.w = pk2(v[6], v[7]);
            *(GAS v4u*)(dst + 8 * k) = o; }
    }
    {
        const int j = 32 * q + (tid >> 4), p = j >> 1, im = j & 1, s_ = tid & 15;
        const float wr_ = PW[((15 - s_) * 64 + p) * 2], wi_ = PW[((15 - s_) * 64 + p) * 2 + 1];
        bf16* dst = F.S5Hm + ((size_t)g * 128 + j) * 256 + 16 * s_;
#pragma unroll
        for (int k = 0; k < 2; ++k) { float v[8];
#pragma unroll
            for (int e = 0; e < 8; ++e) { const int hp = 8 * k + e; const float b_r = BBL[(p * 16 + hp) * 2], b_i = BBL[(p * 16 + hp) * 2 + 1];
                v[e] = im ? (wr_ * b_i + wi_ * b_r) : (wr_ * b_r - wi_ * b_i); }
            v4u o; o.x = pk2(v[0], v[1]); o.y = pk2(v[2], v[3]); o.z = pk2(v[4], v[5]); o.w = pk2(v[6], v[7]);
            *(GAS v4u*)(dst + 8 * k) = o; }
    }
    {
        const int r = 64 * q + (tid >> 3), t = r >> 4, h = r & 15, cb = tid & 7;
        bf16* dst = F.S5Gm + ((size_t)g * 256 + r) * 128 + 16 * cb;
#pragma unroll
        for (int k = 0; k < 2; ++k) { float v[8];
#pragma unroll
            for (int e = 0; e < 4; ++e) { const int p = 8 * cb + 4 * k + e;
                const float c_r = CL[(h * 64 + p) * 2], c_i = CL[(h * 64 + p) * 2 + 1];
                const float wr_ = PW[((t + 1) * 64 + p) * 2], wi_ = PW[((t + 1) * 64 + p) * 2 + 1];
                v[2 * e] = c_r * wr_ - c_i * wi_; v[2 * e + 1] = -(c_r * wi_ + c_i * wr_); }
            v4u o; o.x = pk2(v[0], v[1]); o.y = pk2(v[2], v[3]); o.z = pk2(v[4], v[5]); o.w = pk2(v[6], v[7]);
            *(GAS v4u*)(dst + 8 * k) = o; }
    }
    }
    __syncthreads();
}
__device__ __forceinline__ void p0_prologue(Frame& F) {
    LAS float* scr = (LAS float*)(F.lds + F.wave * 16384);
    const int gw = (int)blockIdx.x * NWAVES + F.wave, NGW = F.G * NWAVES;
    p0_convert_items(F, 0, NITEMS - I_FO + I_FO_P0, gw, NGW, scr);
    {
        f32x4 va[8], vb[8];
        int m = gw;
        if (m < MROWS) rms_row_load(xrow_ptr(F, m), va, F.lane);
        for (; m < MROWS; m += 2 * NGW) {
            const bool hb = m + NGW < MROWS, ha = m + 2 * NGW < MROWS;
            if (hb) rms_row_load(xrow_ptr(F, m + NGW), vb, F.lane);
            rms_row_finish(va, F.SS0 + m, F.XN + (size_t)m * 2048, F.lane);
            if (ha) rms_row_load(xrow_ptr(F, m + 2 * NGW), va, F.lane);
            if (hb) rms_row_finish(vb, F.SS0 + m + NGW, F.XN + (size_t)(m + NGW) * 2048, F.lane);
        }
    }
    const int gt = (int)blockIdx.x * (NWAVES * 64) + F.tid, NGT = F.G * NWAVES * 64;
    for (int i = gt; i < 4096; i += NGT) {
        const int g = i >> 6, p = i & 63;
        const float dt = (float)exp((double)F.log_step[g]);
        const float lr = F.lam_re[i], li = F.lam_im[i];
        const float are = __fmul_rn(lr, dt), aim = __fmul_rn(li, dt);
        const float er = (float)exp((double)are), cs = (float)cos((double)aim), sn = (float)sin((double)aim);
        const float cr = __fmul_rn(er, cs), ci = __fmul_rn(er, sn);
        F.LBR[i] = cr; F.LBI[i] = ci;
        const double nr = (double)cr - 1.0, ni = (double)ci, den = (double)lr * lr + (double)li * li;
        const double fr = (nr * lr + ni * li) / den, fi = (ni * lr - nr * li) / den;
        for (int h = 0; h < 16; ++h) {
            const double br = F.b_re[i * 16 + h], bi = F.b_im[i * 16 + h];
            F.BB[((size_t)g * 128 + 2 * p) * 16 + h] = (bf16)f2bf((float)(fr * br - fi * bi));
            F.BB[((size_t)g * 128 + 2 * p + 1) * 16 + h] = (bf16)f2bf((float)(fr * bi + fi * br));
            F.CMT[((size_t)g * 16 + h) * 128 + 2 * p] = (bf16)f2bf(F.c_re[(g * 16 + h) * 64 + p]);
            F.CMT[((size_t)g * 16 + h) * 128 + 2 * p + 1] = (bf16)f2bf(-F.c_im[(g * 16 + h) * 64 + p]);
        }
    }
    for (int i = gt; i < 2056 * 64; i += NGT) {
        const int pi = i >> 6, j = i & 63;
        const float pos = pi < 2048 ? (float)pi : 16384.f + (float)(pi - 2048);
        const float inv = (float)pow(10000.0, -(double)j / 64.0);
        const float ang = __fmul_rn(pos, inv);
        F.ROPEC[i] = (float)cos((double)ang); F.ROPES[i] = (float)sin((double)ang);
    }
}

constexpr int S5L_BU = 0, S5L_XS = 65536, S5L_EX = 98304;
__device__ __forceinline__ float gelu_tanh(float y) {
    const float c = 0.7978845608028654f * (y + 0.044715f * y * y * y);
    const float e = __expf(2.f * c);
    const float th = 1.f - 2.f * __builtin_amdgcn_rcpf(1.f + e);
    return 0.5f * y * (1.f + th);
}
template <int MODE>
__device__ __forceinline__ void s5_item(Frame& F, const int g, const int idx) {
    LAS unsigned char* lds = F.lds;
    const int lane = F.lane, w = F.wave, p = lane;
    const int rowbase = (MODE == 0) ? idx * 2048 : 8192 + idx * 128;
    const int nblk = (MODE == 0) ? 16 : 1;
    const float lr = F.LBR[g * 64 + p], li = F.LBI[g * 64 + p];
    const int tt = w >> 1, jt0 = 2 * (w & 1);
    bf16x8 bbf[2];
#pragma unroll
    for (int q = 0; q < 2; ++q) bbf[q] = *(const GAS bf16x8*)(F.BB + ((size_t)g * 128 + 32 * (jt0 + q) + (lane & 31)) * 16 + 8 * (lane >> 5));
    bf16x8 cf[4];
#pragma unroll
    for (int s = 0; s < 4; ++s) cf[s] = *(const GAS bf16x8*)(F.CMT + ((size_t)g * 16 + (lane & 15)) * 128 + 32 * s + 8 * (lane >> 4));
    const f32x4 dreg = *(const GAS f32x4*)(F.s5_d + 16 * g + 4 * (lane >> 4));
    float l16r = 1.f, l16i = 0.f;
    float pwr[16], pwi[16];
    if (MODE == 0) {
        float ar = lr, ai = li;
#pragma unroll
        for (int k = 0; k < 16; ++k) { pwr[k] = ar; pwi[k] = ai; const float nr = ar * lr - ai * li, ni = ar * li + ai * lr; ar = nr; ai = ni; }
        l16r = pwr[15]; l16i = pwi[15];
    }
    const int xlane = 16 * (p >> 2) + 4 * (p & 3);
    float Xr = 0.f, Xi = 0.f;
    bf16x8 uf = *(const GAS bf16x8*)(F.U + (size_t)(rowbase + 32 * tt + (lane & 31)) * 1024 + 16 * g + 8 * (lane >> 5));
    for (int blk = 0; blk < nblk; ++blk) {
        const int rb = rowbase + 128 * blk;
#pragma unroll
        for (int q = 0; q < 2; ++q) {
            f32x16 z;
#pragma unroll
            for (int e = 0; e < 16; ++e) z[e] = 0.f;
            const f32x16 d = __builtin_amdgcn_mfma_f32_32x32x16_bf16(uf, bbf[q], z, 0, 0, 0);
            const int j = 32 * (jt0 + q) + (lane & 31);
#pragma unroll
            for (int e = 0; e < 16; ++e) { const int t = 32 * tt + (e & 3) + 8 * (e >> 2) + 4 * (lane >> 5);
                *(LAS float*)(lds + S5L_BU + (t * 128 + j) * 4) = d[e]; }
        }
        if (blk + 1 < nblk) uf = *(const GAS bf16x8*)(F.U + (size_t)(rb + 128 + 32 * tt + (lane & 31)) * 1024 + 16 * g + 8 * (lane >> 5));
        const size_t r = (size_t)(rb + 16 * w + (lane & 15));
        const int h0 = 16 * g + 4 * (lane >> 4);
        const u32x2v uw = *(const GAS u32x2v*)(F.U + r * 1024 + h0);
        LDS_BARRIER();
        if (MODE == 0) {
            float locr[16], loci[16];
            f32x2v b[16];
#pragma unroll
            for (int k = 0; k < 16; ++k) b[k] = *(const LAS f32x2v*)(lds + S5L_BU + ((16 * w + k) * 128 + 2 * p) * 4);
            float xr = 0.f, xi = 0.f;
#pragma unroll
            for (int k = 0; k < 16; ++k) { const float nr = lr * xr - li * xi + b[k].x, ni = lr * xi + li * xr + b[k].y; xr = nr; xi = ni; locr[k] = xr; loci[k] = xi; }
            *(LAS f32x2v*)(lds + S5L_EX + (w * 64 + p) * 8) = (f32x2v){xr, xi};
            LDS_BARRIER();
            float cr = Xr, ci = Xi, Cwr = 0.f, Cwi = 0.f;
#pragma unroll
            for (int ww = 0; ww < 8; ++ww) {
                if (ww == w) { Cwr = cr; Cwi = ci; }
                const f32x2v e = *(const LAS f32x2v*)(lds + S5L_EX + (ww * 64 + p) * 8);
                const float nr = l16r * cr - l16i * ci + e.x, ni = l16r * ci + l16i * cr + e.y; cr = nr; ci = ni;
            }
            Xr = cr; Xi = ci;
#pragma unroll
            for (int k = 0; k < 16; ++k) {
                const float fr = locr[k] + pwr[k] * Cwr - pwi[k] * Cwi, fi = loci[k] + pwr[k] * Cwi + pwi[k] * Cwr;
                *(LAS unsigned*)(lds + S5L_XS + 4096 * w + 256 * k + (xlane ^ (16 * (((k & 3) << 2) | ((k >> 2) & 3)))) ) = cvtpk(fr, fi);
            }
        } else {
#pragma unroll
            for (int s2 = 0; s2 < 2; ++s2) {
                const int seq = 16 * idx + 2 * w + s2;
                float xr = F.st_re[((size_t)seq * 64 + g) * 64 + p], xi = F.st_im[((size_t)seq * 64 + g) * 64 + p];
#pragma unroll
                for (int k = 0; k < 8; ++k) {
                    const int tl = 16 * w + 8 * s2 + k;
                    const f32x2v b = *(const LAS f32x2v*)(lds + S5L_BU + (tl * 128 + 2 * p) * 4);
                    const float nr = lr * xr - li * xi + b.x, ni = lr * xi + li * xr + b.y; xr = nr; xi = ni;
                    *(LAS unsigned*)(lds + S5L_XS + 4096 * w + 256 * (8 * s2 + k) + (xlane ^ (16 * ((((8 * s2 + k) & 3) << 2) | (((8 * s2 + k) >> 2) & 3))))) = cvtpk(xr, xi);
                }
                F.o_s5re_s[((size_t)seq * 64 + g) * 64 + p] = xr; F.o_s5im_s[((size_t)seq * 64 + g) * 64 + p] = xi;
            }
        }
        LDS_BARRIER();
        f32x4 ya = {0.f, 0.f, 0.f, 0.f};
#pragma unroll
        for (int s = 0; s < 4; ++s) {
            const bf16x8 xf = *(const LAS bf16x8*)(lds + S5L_XS + offb(16 * w + (lane & 15), 4 * s + (lane >> 4)));
            ya = __builtin_amdgcn_mfma_f32_16x16x32_bf16(cf[s], xf, ya, 0, 0, 0);
        }
        const float y0 = gelu_tanh(ya[0] + dreg[0] * bflo(uw.x)), y1 = gelu_tanh(ya[1] + dreg[1] * bfhi(uw.x));
        const float y2 = gelu_tanh(ya[2] + dreg[2] * bflo(uw.y)), y3 = gelu_tanh(ya[3] + dreg[3] * bfhi(uw.y));
        u32x2v yo; yo.x = cvtpk(y0, y1); yo.y = cvtpk(y2, y3);
        *(GAS u32x2v*)(F.YS5 + r * 1024 + h0) = yo;
    }
    if (MODE == 0 && w == 0) { F.o_s5re_p[((size_t)idx * 64 + g) * 64 + p] = Xr; F.o_s5im_p[((size_t)idx * 64 + g) * 64 + p] = Xi; }
}

constexpr int S5G_UI = 0, S5G_HX = 65536;
__device__ __forceinline__ void s5_prompt_gemm(Frame& F, const int g, const int n) {
    LAS unsigned char* lds = F.lds;
    const int tid = F.tid, lane = F.lane, w = F.wave, p = lane;
    const size_t rowbase = (size_t)n * 2048;
#pragma unroll
    for (int i = 0; i < 8; ++i) { const int q = tid + 512 * i, token = q >> 1, half = q & 1, c = token >> 4, s_ = token & 15;
        const v4u v = *(const GAS v4u*)(F.U + (rowbase + token) * 1024 + 16 * g + 8 * half);
        *(LAS v4u*)(lds + S5G_UI + 512 * c + 16 * ((2 * s_ + half) ^ (c & 15))) = v; }
    bf16x8 hf[8];
#pragma unroll
    for (int s = 0; s < 8; ++s) hf[s] = *(const GAS bf16x8*)(F.S5Hm + ((size_t)g * 128 + 16 * w + (lane & 15)) * 256 + 32 * s + 8 * (lane >> 4));
    const float lr = F.LBR[g * 64 + p], li = F.LBI[g * 64 + p];
    LDS_BARRIER();
#pragma unroll 2
    for (int ct = 0; ct < 8; ++ct) {
        f32x4 a = {0.f, 0.f, 0.f, 0.f};
        const int c = 16 * ct + (lane & 15);
#pragma unroll
        for (int s = 0; s < 8; ++s) {
            const bf16x8 uf = *(const LAS bf16x8*)(lds + S5G_UI + 512 * c + 16 * ((4 * s + (lane >> 4)) ^ (lane & 15)));
            a = __builtin_amdgcn_mfma_f32_16x16x32_bf16(hf[s], uf, a, 0, 0, 0);
        }
        *(LAS f32x4*)(lds + S5G_HX + 512 * c + 4 * (16 * w + 4 * (lane >> 4))) = a;
    }
    const int t0 = w, t1 = 15 - w;
    bf16x8 l0[8], l1[8], g0[4], g1[4];
#pragma unroll
    for (int s = 0; s < 8; ++s) { l0[s] = *(const GAS bf16x8*)(F.S5Lm + ((size_t)g * 256 + 16 * t0 + (lane & 15)) * 256 + 32 * s + 8 * (lane >> 4));
                                  l1[s] = *(const GAS bf16x8*)(F.S5Lm + ((size_t)g * 256 + 16 * t1 + (lane & 15)) * 256 + 32 * s + 8 * (lane >> 4)); }
#pragma unroll
    for (int s = 0; s < 4; ++s) { g0[s] = *(const GAS bf16x8*)(F.S5Gm + ((size_t)g * 256 + 16 * t0 + (lane & 15)) * 128 + 32 * s + 8 * (lane >> 4));
                                  g1[s] = *(const GAS bf16x8*)(F.S5Gm + ((size_t)g * 256 + 16 * t1 + (lane & 15)) * 128 + 32 * s + 8 * (lane >> 4)); }
    LDS_BARRIER();
    if (w == 0) {
        float Lr = lr, Li = li;
#pragma unroll
        for (int k = 0; k < 4; ++k) { const float nr = Lr * Lr - Li * Li, ni = 2.f * Lr * Li; Lr = nr; Li = ni; }
        float xr = 0.f, xi = 0.f;
        const int xlane = 16 * (p >> 2) + 4 * (p & 3);
        for (int c8 = 0; c8 < 128; c8 += 8) {
            f32x2v b[8];
#pragma unroll
            for (int k = 0; k < 8; ++k) b[k] = *(const LAS f32x2v*)(lds + S5G_HX + 512 * (c8 + k) + 8 * p);
#pragma unroll
            for (int k = 0; k < 8; ++k) {
                const int cc = c8 + k;
                *(LAS unsigned*)(lds + S5G_HX + 256 * cc + (xlane ^ (16 * (((cc & 3) << 2) | ((cc >> 2) & 3))))) = cvtpk(xr, xi);
                const float nr = Lr * xr - Li * xi + b[k].x, ni = Lr * xi + Li * xr + b[k].y; xr = nr; xi = ni;
            }
        }
        F.o_s5re_p[((size_t)n * 64 + g) * 64 + p] = xr; F.o_s5im_p[((size_t)n * 64 + g) * 64 + p] = xi;
    }
    LDS_BARRIER();
#pragma unroll 1
    for (int ct = 0; ct < 8; ++ct) {
        f32x4 a0 = {0.f, 0.f, 0.f, 0.f}, a1 = {0.f, 0.f, 0.f, 0.f};
        const int c = 16 * ct + (lane & 15);
#pragma unroll
        for (int s = 0; s < 8; ++s) {
            const bf16x8 uf = *(const LAS bf16x8*)(lds + S5G_UI + 512 * c + 16 * ((4 * s + (lane >> 4)) ^ (lane & 15)));
            a0 = __builtin_amdgcn_mfma_f32_16x16x32_bf16(l0[s], uf, a0, 0, 0, 0);
            a1 = __builtin_amdgcn_mfma_f32_16x16x32_bf16(l1[s], uf, a1, 0, 0, 0);
        }
#pragma unroll
        for (int s = 0; s < 4; ++s) {
            const bf16x8 xf = *(const LAS bf16x8*)(lds + S5G_HX + offb(c, 4 * s + (lane >> 4)));
            a0 = __builtin_amdgcn_mfma_f32_16x16x32_bf16(g0[s], xf, a0, 0, 0, 0);
            a1 = __builtin_amdgcn_mfma_f32_16x16x32_bf16(g1[s], xf, a1, 0, 0, 0);
        }
        const int h0 = 16 * g + 4 * (lane >> 4);
        { u32x2v yo; yo.x = cvtpk(gelu_tanh(a0[0]), gelu_tanh(a0[1])); yo.y = cvtpk(gelu_tanh(a0[2]), gelu_tanh(a0[3]));
          *(GAS u32x2v*)(F.YS5 + (rowbase + 16 * c + t0) * 1024 + h0) = yo; }
        { u32x2v yo; yo.x = cvtpk(gelu_tanh(a1[0]), gelu_tanh(a1[1])); yo.y = cvtpk(gelu_tanh(a1[2]), gelu_tanh(a1[3]));
          *(GAS u32x2v*)(F.YS5 + (rowbase + 16 * c + t1) * 1024 + h0) = yo; }
    }
}

constexpr int RL_K = 0, RL_V = 65536, RL_P = 73728, RL_RT = 106496;
__device__ __forceinline__ void ret_prompt_item(Frame& F, const int n, const int h, const int part) {
    LAS unsigned char* lds = F.lds;
    const int tid = F.tid, lane = F.lane, w = F.wave;
    const float gam = 1.f - exp2f(-5.f - (float)h);
    const float cd = exp2f(128.f * __log2f(gam));
    LAS unsigned char* P = lds + RL_P + w * 4096;
#pragma unroll
    for (int i = 0; i < 4; ++i) *(LAS v4u*)(P + lane * 16 + i * 1024) = (v4u){0u, 0u, 0u, 0u};
    if (tid < 256) *(LAS v4u*)(lds + RL_RT + tid * 16) = (v4u){0u, 0u, 0u, 0u};
    const unsigned lq = (unsigned)(lane & 15) >> 2, lp = (unsigned)lane & 3u, lg = (unsigned)lane >> 4;
    const unsigned fl = ((unsigned)(lane & 3) << 2) | ((unsigned)(lane >> 2) & 3u);
    unsigned kx[4];
#pragma unroll
    for (int s = 0; s < 4; ++s) kx[s] = 256u * (unsigned)(lane & 15) + 16u * ((4u * s + lg) ^ fl);
    const unsigned pwbase = 256u * (unsigned)(lane & 15) + 8u * (lg & 1u), pl16 = 16u * (((unsigned)lane >> 5) ^ fl);
    const unsigned vb0 = lg * 256u + lq * 32u + lp * 8u, vh = (lg & 1u) * 128u;
    unsigned kso[4];
#pragma unroll
    for (int i = 0; i < 4; ++i) { const unsigned row = 4u * (4u * w + i) + lg, ch = (unsigned)(lane & 15) ^ ((lg << 2) | (unsigned)i); kso[i] = (row * 1024u + 8u * ch) * 2u; }
    const size_t rowbase = (size_t)n * 2048;
    const char* kbase = (const char*)(F.Kb + rowbase * 1024 + h * 128);
    const bf16* vsrc = F.V + (rowbase + (tid >> 2)) * 1024 + h * 128 + 16 * part + 4 * (tid & 3);
    const unsigned vdst = (unsigned)((tid >> 5) * 256 + ((((tid >> 4) & 1) ^ ((tid >> 5) & 1)) * 128) + ((tid >> 2) & 3) * 32 + (tid & 3) * 8);
    const bf16* qsrc = F.Q + (rowbase + 16 * w + (lane & 15)) * 1024 + h * 128 + 8 * lg;
    v4u kreg[4];
#define RP_KLOAD(c_) do { _Pragma("unroll") for (int _i = 0; _i < 4; ++_i) kreg[_i] = *(const GAS v4u*)(kbase + (size_t)(c_) * (128 * 1024 * 2) + kso[_i]); } while (0)
    RP_KLOAD(0);
    u32x2v vreg = *(const GAS u32x2v*)(vsrc);
    bf16x8 qn[4];
#pragma unroll
    for (int s = 0; s < 4; ++s) qn[s] = *(const GAS bf16x8*)(qsrc + 32 * s);
    f32x4 accR = {0.f, 0.f, 0.f, 0.f};
    u32x2v opend = {0u, 0u};
    for (int c = 0; c < 16; ++c) {
        *(LAS u32x2v*)(lds + RL_V + (c & 1) * 4096 + vdst) = vreg;
#pragma unroll
        for (int i = 0; i < 4; ++i) *(LAS v4u*)(lds + RL_K + (c & 1) * 32768 + (4 * w + i) * 1024 + lane * 16) = kreg[i];
        LDS_BARRIER();
        bf16x8 qf[4];
#pragma unroll
        for (int s = 0; s < 4; ++s) qf[s] = qn[s];
        if (c < 15) {
            RP_KLOAD(c + 1);
            vreg = *(const GAS u32x2v*)(vsrc + (size_t)(c + 1) * 128 * 1024);
#pragma unroll
            for (int s = 0; s < 4; ++s) qn[s] = *(const GAS bf16x8*)(qsrc + (size_t)(c + 1) * 128 * 1024 + 32 * s);
        }
        asm volatile("" ::: "memory");
        if (c > 0) *(GAS u32x2v*)(F.Ob + (rowbase + 128 * (c - 1) + 16 * w + (lane & 15)) * 1024 + h * 128 + 16 * part + 4 * lg) = opend;
        asm volatile("" ::: "memory");
        LAS unsigned char* KI = lds + RL_K + (c & 1) * 32768;
        LAS unsigned char* VI = lds + RL_V + (c & 1) * 4096;
        {
            bf16x8 kfc[4], kfn[4];
#pragma unroll
            for (int s = 0; s < 4; ++s) { kfc[s] = *(const LAS bf16x8*)(KI + kx[s]); kfn[s] = kfc[s]; }
            for (int cb = 0; cb <= w; ++cb) {
                if (cb < w) {
#pragma unroll
                    for (int s = 0; s < 4; ++s) kfn[s] = *(const LAS bf16x8*)(KI + 4096 * (cb + 1) + kx[s]);
                }
                f32x4 st = {0.f, 0.f, 0.f, 0.f};
#pragma unroll
                for (int s = 0; s < 4; ++s) st = __builtin_amdgcn_mfma_f32_16x16x32_bf16(kfc[s], qf[s], st, 0, 0, 0);
                if (cb == w) {
#pragma unroll
                    for (int e = 0; e < 4; ++e) if ((int)(4 * lg) + e > (lane & 15)) st[e] = 0.f;
                }
                u32x2v pw; pw.x = cvtpk(st[0], st[1]); pw.y = cvtpk(st[2], st[3]);
                *(LAS u32x2v*)(P + pwbase + ((32u * (unsigned)cb) ^ pl16)) = pw;
#pragma unroll
                for (int s = 0; s < 4; ++s) kfc[s] = kfn[s];
            }
        }
        bf16x8 vf[4], kt[4];
#pragma unroll
        for (int s = 0; s < 4; ++s) {
            vf[s] = tr_pair(VI, 1024u * s + vb0 + vh, 1024u * s + vb0 + (vh ^ 128u));
            const unsigned r0 = 32 * s + 8 * lg + lq;
            kt[s] = tr_pair(KI, offb(r0, 2 * w + (lp >> 1)) + 8 * (lp & 1), offb(r0 + 4, 2 * w + (lp >> 1)) + 8 * (lp & 1));
        }
        f32x4 oi = {0.f, 0.f, 0.f, 0.f}, oc = {0.f, 0.f, 0.f, 0.f};
#pragma unroll
        for (int s = 0; s < 4; ++s) {
            const bf16x8 pf = *(const LAS bf16x8*)(P + kx[s]);
            oi = __builtin_amdgcn_mfma_f32_16x16x32_bf16(vf[s], pf, oi, 0, 0, 0);
            const bf16x8 rf = *(const LAS bf16x8*)(lds + RL_RT + (c & 1) * 4096 + kx[s]);
            oc = __builtin_amdgcn_mfma_f32_16x16x32_bf16(rf, qf[s], oc, 0, 0, 0);
        }
        accR = accR * cd;
#pragma unroll
        for (int s = 0; s < 4; ++s) accR = __builtin_amdgcn_mfma_f32_16x16x32_bf16(kt[s], vf[s], accR, 0, 0, 0);
        { u32x2v rw; rw.x = cvtpk(accR[0], accR[1]); rw.y = cvtpk(accR[2], accR[3]);
          *(LAS u32x2v*)(lds + RL_RT + ((c + 1) & 1) * 4096 + pwbase + ((32u * (unsigned)w) ^ pl16)) = rw; }
        { const f32x4 o = oi + oc * cd; opend.x = cvtpk(o[0], o[1]); opend.y = cvtpk(o[2], o[3]); }
    }
    *(GAS u32x2v*)(F.Ob + (rowbase + 128 * 15 + 16 * w + (lane & 15)) * 1024 + h * 128 + 16 * part + 4 * lg) = opend;
#undef RP_KLOAD
#pragma unroll
    for (int e = 0; e < 4; ++e) F.o_ret_p[(((size_t)n * 8 + h) * 128 + 16 * w + 4 * lg + e) * 128 + 16 * part + (lane & 15)] = accR[e];
    LDS_BARRIER();
}

constexpr int SL_Q = 0, SL_K = 4096, SL_SC = 8192, SL_OCP = 8704;
__device__ __forceinline__ void ret_sample_item(Frame& F, const int n, const int h) {
    LAS unsigned char* lds = F.lds;
    const int tid = F.tid, e = tid & 127, dq = tid >> 7;
    const float gam = 1.f - exp2f(-5.f - (float)h), l2g = __log2f(gam);
    const size_t rbase = ((size_t)n * 8 + h) * 128 * 128;
    const int row0 = 8192 + 8 * n;
    float R[32];
#pragma unroll
    for (int dd = 0; dd < 32; ++dd) R[dd] = F.st_ret[rbase + (size_t)(32 * dq + dd) * 128 + e];
#pragma unroll
    for (int i = 0; i < 2; ++i) { const int q = tid + 512 * i, t = q >> 7, d = q & 127;
        const size_t o = (size_t)(row0 + t) * 1024 + h * 128 + d;
        *(LAS float*)(lds + SL_Q + q * 4) = bflo((unsigned)F.Q[o]);
        *(LAS float*)(lds + SL_K + q * 4) = bflo((unsigned)F.Kb[o]) * exp2f(l2g * (float)(7 - t)); }
    float v[8];
#pragma unroll
    for (int t = 0; t < 8; ++t) v[t] = bflo((unsigned)F.V[(size_t)(row0 + t) * 1024 + h * 128 + e]);
    LDS_BARRIER();
    if (tid < 64) { const int i = tid >> 3, j = tid & 7; float s = 0.f;
        if (j <= i) { for (int d = 0; d < 128; ++d) s += *(const LAS float*)(lds + SL_Q + (i * 128 + d) * 4) * *(const LAS float*)(lds + SL_K + (j * 128 + d) * 4); s *= exp2f(l2g * (float)(i - 7)); }
        *(LAS float*)(lds + SL_SC + tid * 4) = s; }
    float oc[8];
#pragma unroll
    for (int t = 0; t < 8; ++t) oc[t] = 0.f;
    const float g8 = exp2f(8.f * l2g);
#pragma unroll
    for (int d4 = 0; d4 < 8; ++d4) {
        f32x4 qv[8], kv[8];
#pragma unroll
        for (int t = 0; t < 8; ++t) { qv[t] = *(const LAS f32x4*)(lds + SL_Q + (t * 128 + 32 * dq + 4 * d4) * 4); kv[t] = *(const LAS f32x4*)(lds + SL_K + (t * 128 + 32 * dq + 4 * d4) * 4); }
#pragma unroll
        for (int k = 0; k < 4; ++k) {
            const int dd = 4 * d4 + k; const float r = R[dd]; float rn = g8 * r;
#pragma unroll
            for (int t = 0; t < 8; ++t) { oc[t] += qv[t][k] * r; rn += kv[t][k] * v[t]; }
            R[dd] = rn;
        }
        asm volatile("" ::: "memory");
    }
#pragma unroll
    for (int dd = 0; dd < 32; ++dd) F.o_ret_s[rbase + (size_t)(32 * dq + dd) * 128 + e] = R[dd];
#pragma unroll
    for (int t = 0; t < 8; ++t) *(LAS float*)(lds + SL_OCP + ((dq * 8 + t) * 128 + e) * 4) = oc[t];
    LDS_BARRIER();
#pragma unroll
    for (int k = 0; k < 2; ++k) { const int t = 2 * dq + k;
        float o = 0.f;
#pragma unroll
        for (int qq = 0; qq < 4; ++qq) o += *(const LAS float*)(lds + SL_OCP + ((qq * 8 + t) * 128 + e) * 4);
        o *= exp2f(l2g * (float)(t + 1));
#pragma unroll
        for (int j = 0; j < 8; ++j) if (j <= t) o += *(const LAS float*)(lds + SL_SC + (t * 8 + j) * 4) * v[j];
        F.Ob[(size_t)(row0 + t) * 1024 + h * 128 + e] = (bf16)f2bf(o); }
    LDS_BARRIER();
}

__device__ __forceinline__ void ret_norm_rows(Frame& F, int first, int stride) {
    const int lane = F.lane, col = (lane >> 3) * 128 + (lane & 7) * 16;
    f32x4 gw[4];
#pragma unroll
    for (int i = 0; i < 4; ++i) gw[i] = *(const GAS f32x4*)(F.gn_w + col + 4 * i);
    for (int r0 = first; r0 < MROWS; r0 += 2 * stride) {
        v4u ow[2][2], gv[2][2];
#pragma unroll
        for (int k = 0; k < 2; ++k) { const int r = r0 + k * stride;
            if (r < MROWS) {
#pragma unroll
                for (int i = 0; i < 2; ++i) { ow[k][i] = *(const GAS v4u*)(F.Ob + (size_t)r * 1024 + col + 8 * i); gv[k][i] = *(const GAS v4u*)(F.Gt + (size_t)r * 1024 + col + 8 * i); } } }
#pragma unroll
        for (int k = 0; k < 2; ++k) { const int r = r0 + k * stride;
            if (r < MROWS) {
                float x[16], g[16];
#pragma unroll
                for (int i = 0; i < 2; ++i)
#pragma unroll
                    for (int j = 0; j < 4; ++j) { x[8 * i + 2 * j] = bflo(ow[k][i][j]); x[8 * i + 2 * j + 1] = bfhi(ow[k][i][j]); g[8 * i + 2 * j] = bflo(gv[k][i][j]); g[8 * i + 2 * j + 1] = bfhi(gv[k][i][j]); }
                float s = 0.f;
#pragma unroll
                for (int j = 0; j < 16; ++j) s += x[j];
                s += __shfl_xor(s, 1); s += __shfl_xor(s, 2); s += __shfl_xor(s, 4);
                const float mu = s * (1.f / 128.f);
                float q = 0.f;
#pragma unroll
                for (int j = 0; j < 16; ++j) { x[j] -= mu; q += x[j] * x[j]; }
                q += __shfl_xor(q, 1); q += __shfl_xor(q, 2); q += __shfl_xor(q, 4);
                const float rs = rsqrtf(q * (1.f / 128.f) + 1e-6f);
                v4u o[2];
#pragma unroll
                for (int i = 0; i < 2; ++i)
#pragma unroll
                    for (int j = 0; j < 4; ++j) { const int e = 8 * i + 2 * j; o[i][j] = pk2(g[e] * (x[e] * rs * gw[e >> 2][e & 3]), g[e + 1] * (x[e + 1] * rs * gw[(e + 1) >> 2][(e + 1) & 3])); }
#pragma unroll
                for (int i = 0; i < 2; ++i) *(GAS v4u*)(F.MIX + (size_t)r * 2048 + 1024 + col + 8 * i) = o[i];
            } }
    }
}
__device__ __forceinline__ void sample_rows_reduce(Frame& F, const bf16* slab, float* ss) {
    const int gwv = (int)blockIdx.x * NWAVES + F.wave, NGW = F.G * NWAVES, lane = F.lane;
    for (int m = 8192 + gwv; m < MROWS; m += NGW) {
        const GAS v4u* xr = (const GAS v4u*)(F.XN + (size_t)m * 2048) + lane;
        f32x4 v[8]; float s = 0.f;
#pragma unroll
        for (int j = 0; j < 4; ++j) { const v4u w = xr[64 * j];
            v[2 * j] = (f32x4){bflo(w.x), bfhi(w.x), bflo(w.y), bfhi(w.y)}; v[2 * j + 1] = (f32x4){bflo(w.z), bfhi(w.z), bflo(w.w), bfhi(w.w)}; }
#pragma unroll 2
        for (int k = 0; k < 4; ++k) {
            const GAS v4u* sr = (const GAS v4u*)(slab + ((size_t)k * 1024 + (m - 8192)) * 2048) + lane;
#pragma unroll
            for (int j = 0; j < 4; ++j) { const v4u w = sr[64 * j];
                v[2 * j] += (f32x4){bflo(w.x), bfhi(w.x), bflo(w.y), bfhi(w.y)}; v[2 * j + 1] += (f32x4){bflo(w.z), bfhi(w.z), bflo(w.w), bfhi(w.w)}; }
        }
        GAS v4u* o16 = (GAS v4u*)(F.XN + (size_t)m * 2048) + lane;
#pragma unroll
        for (int j = 0; j < 4; ++j) { const f32x4 a = v[2 * j], c = v[2 * j + 1];
            s += ((a.x * a.x + a.y * a.y) + (a.z * a.z + a.w * a.w)) + ((c.x * c.x + c.y * c.y) + (c.z * c.z + c.w * c.w));
            v4u o; o.x = pk2(a.x, a.y); o.y = pk2(a.z, a.w); o.z = pk2(c.x, c.y); o.w = pk2(c.z, c.w); o16[64 * j] = o; }
        s = wave_sum(s);
        if (lane == 0) ss[m] = s;
    }
}
__device__ __forceinline__ void final_norm(Frame& F, const bf16* slab) {
    const int gwv = (int)blockIdx.x * NWAVES + F.wave, NGW = F.G * NWAVES, lane = F.lane;
    for (int m = gwv; m < MROWS; m += NGW) {
        const GAS v4u* xr = (const GAS v4u*)(F.XN + (size_t)m * 2048) + lane;
        f32x4 v[8];
#pragma unroll
        for (int j = 0; j < 4; ++j) { const v4u w = xr[64 * j];
            v[2 * j] = (f32x4){bflo(w.x), bfhi(w.x), bflo(w.y), bfhi(w.y)}; v[2 * j + 1] = (f32x4){bflo(w.z), bfhi(w.z), bflo(w.w), bfhi(w.w)}; }
        if (m >= 8192) {
#pragma unroll 2
            for (int k = 0; k < 8; ++k) {
                const GAS v4u* sr = (const GAS v4u*)(slab + ((size_t)k * 1024 + (m - 8192)) * 2048) + lane;
#pragma unroll
                for (int j = 0; j < 4; ++j) { const v4u w = sr[64 * j];
                    v[2 * j] += (f32x4){bflo(w.x), bfhi(w.x), bflo(w.y), bfhi(w.y)}; v[2 * j + 1] += (f32x4){bflo(w.z), bfhi(w.z), bflo(w.w), bfhi(w.w)}; }
            }
        }
        float s = 0.f;
#pragma unroll
        for (int j = 0; j < 8; ++j) s += (v[j].x * v[j].x + v[j].y * v[j].y) + (v[j].z * v[j].z + v[j].w * v[j].w);
        const float sc = rsqrtf(wave_sum(s) * (1.f / 2048.f) + 1e-6f);
        GAS f32x4* yr = (GAS f32x4*)(F.Y + (size_t)m * 2048) + 2 * lane;
        const GAS f32x4* gr = (const GAS f32x4*)F.norm_final + 2 * lane;
#pragma unroll
        for (int j = 0; j < 4; ++j) { yr[128 * j] = v[2 * j] * sc * gr[128 * j]; yr[128 * j + 1] = v[2 * j + 1] * sc * gr[128 * j + 1]; }
    }
}

struct Args { const float* in[23]; float* out; unsigned char* ws; int ph_lo, ph_hi, li, pad; };
__global__ void __launch_bounds__(NWAVES * 64, 2) mk_fwd(Args args) {
    extern __shared__ __attribute__((aligned(16))) unsigned char lds[];
    Frame F;
    F.lds = (LAS unsigned char*)lds;
    F.MISC = (volatile LAS unsigned*)(F.lds + MISC_OFF);
    F.tid = threadIdx.x; F.lane = F.tid & 63; F.wave = __builtin_amdgcn_readfirstlane(F.tid >> 6);
    F.G = gridDim.x;
    unsigned char* ws = args.ws;
    F.ctl = (gu32*)(ws + WS_CTL);
    F.x_prompt = args.in[0]; F.x_sample = args.in[1]; F.st_re = args.in[2]; F.st_im = args.in[3]; F.st_ret = args.in[4]; F.norm_mix = args.in[5]; F.w_in = args.in[6];
    F.lam_re = args.in[7]; F.lam_im = args.in[8]; F.log_step = args.in[9]; F.b_re = args.in[10]; F.b_im = args.in[11]; F.c_re = args.in[12]; F.c_im = args.in[13];
    F.s5_d = args.in[14]; F.w_glu = args.in[15]; F.b_glu = args.in[16]; F.gn_w = args.in[17]; F.w_out = args.in[18]; F.norm_ffn = args.in[19]; F.w_ffn_in = args.in[20];
    F.w_ffn_out = args.in[21]; F.norm_final = args.in[22];
    F.Y = args.out;
    F.o_s5re_p = F.Y + (size_t)MROWS * 2048; F.o_s5im_p = F.o_s5re_p + 4 * 64 * 64; F.o_ret_p = F.o_s5im_p + 4 * 64 * 64;
    F.o_s5re_s = F.o_ret_p + (size_t)4 * 8 * 128 * 128; F.o_s5im_s = F.o_s5re_s + (size_t)128 * 64 * 64; F.o_ret_s = F.o_s5im_s + (size_t)128 * 64 * 64;
    F.LBR = (float*)(ws + WS_PAR); F.LBI = F.LBR + 4096; F.ROPEC = F.LBI + 4096; F.ROPES = F.ROPEC + 2056 * 64;
    F.SS0 = (float*)(ws + WS_PAR + 1736704);
    F.BB = (bf16*)(ws + WS_PAR + 1179648); F.CMT = F.BB + 64 * 128 * 16;
    F.WIN_T = (bf16*)(ws + WS_WIN); F.WGLU_T = (bf16*)(ws + WS_WGLU); F.WOUT_T = (bf16*)(ws + WS_WOUT); F.WFI_T = (bf16*)(ws + WS_WFI); F.WFO_T = (bf16*)(ws + WS_WFO);
    F.XN = (bf16*)(ws + WS_XN); F.U = (bf16*)(ws + WS_U); F.Q = (bf16*)(ws + WS_Q); F.Kb = (bf16*)(ws + WS_K); F.V = (bf16*)(ws + WS_V); F.Gt = (bf16*)(ws + WS_G);
    F.S5Lm = (bf16*)(ws + WS_S5L); F.S5Hm = (bf16*)(ws + WS_S5H); F.S5Gm = (bf16*)(ws + WS_S5G);
    F.Ob = (bf16*)(ws + WS_O); F.YS5 = (bf16*)(ws + WS_YS5); F.MIX = (bf16*)(ws + WS_MIX); F.ACT = (bf16*)(ws + WS_ACT);
    for (int u = F.tid; u < (LDS_BYTES - LDSCTL_OFF) / 4; u += NWAVES * 64) ((LAS unsigned*)(F.lds + LDSCTL_OFF))[u] = 0u;
    __syncthreads();
    XcdBarrier bar; bar.bar = (unsigned*)(F.ctl + CW_BAR); bar.x = 0; bar.st = nullptr;
    if (N_LAUNCHES == 1) bar = xcd_barrier_post((unsigned*)(F.ctl + CW_BAR), F.MISC + 8);
#define GRID_BAR() do { if (N_LAUNCHES == 1) xcd_barrier(bar); } while (0)
    const int lo = args.ph_lo, hi = args.ph_hi;
#define IN(k) (lo <= (k) && (k) < hi)
#define BOTH(k) (IN(k) && IN((k) + 1))
    const int bx = (int)blockIdx.x;

    if (IN(0)) { p0_prologue(F); if (BOTH(0)) GRID_BAR(); }

    if (IN(1)) {
        pg8::Gemm g{F.XN, F.WIN_T, MROWS, 5120, 2048}; pg8::StaticOrder S; S.init(MROWS, 5120, 2048, F.G, bx);
        pg8::EpiProj E{F.U, F.ROPEC, F.ROPES, F.SS0};
        pg8::gemm_phase<pg8::EpiProj, pg8::StaticOrder, PG8_ALIGN, PG8_SP2>(F.lds, g, S, E);
        {
            const int nlast = 720 - (720 / F.G) * F.G, nfree = F.G - nlast;
            __syncthreads();
            if (nlast == 0 || nfree <= 0) { for (int gg = bx; gg < 64; gg += F.G) s5_precompute(F, gg); }
            else if (bx >= nlast) { for (int gg = bx - nlast; gg < 64; gg += nfree) s5_precompute(F, gg); }
        }
        if (BOTH(1)) GRID_BAR();
    }

    if (IN(2)) {
        __syncthreads();
        for (int it = bx; it < 256; it += F.G) { s5_prompt_gemm(F, ((it & 7) << 3) | ((it >> 3) & 7), it >> 6); __syncthreads(); }
        for (int it = bx; it < 512; it += F.G) { s5_item<1>(F, ((it & 7) << 3) | ((it >> 3) & 7), it >> 6); __syncthreads(); }
        for (int it = bx; it < 256; it += F.G) {
            const int xcd = it & 7, slot = it >> 3, part = slot & 7, nh = xcd + 8 * (slot >> 3);
            ret_prompt_item(F, nh >> 3, nh & 7, part); __syncthreads(); }
        for (int it = bx; it < 1024; it += F.G) ret_sample_item(F, it >> 3, it & 7);
        if (BOTH(2)) GRID_BAR();
    }

    if (IN(3)) {
        pg8::StaticOrder S; S.init(MROWS, 1024, 1024, F.G, bx);
        pg8::Unit u0;
        if (S.next(0, u0)) {
            pg8::Gemm g{F.YS5, F.WGLU_T, MROWS, 1024, 1024};
            pg8::EpiGlu E{F.YS5, F.MIX, F.b_glu};
            pg8::gemm_phase<pg8::EpiGlu, pg8::StaticOrder, PG8_ALIGN, PG8_SP2>(F.lds, g, S, E);
        } else {
            const int nfree = F.G - 144;
            ret_norm_rows(F, (bx - 144) * NWAVES + F.wave, nfree * NWAVES);
            p0_convert_items(F, NITEMS - I_FO + I_FO_P0, NITEMS, (bx - 144) * NWAVES + F.wave, nfree * NWAVES, (LAS float*)(F.lds + F.wave * 16384));
        }
        if (F.G <= 144) { ret_norm_rows(F, bx * NWAVES + F.wave, F.G * NWAVES); p0_convert_items(F, NITEMS - I_FO + I_FO_P0, NITEMS, bx * NWAVES + F.wave, F.G * NWAVES, (LAS float*)(F.lds + F.wave * 16384)); }
        if (BOTH(3)) GRID_BAR();
    }

    if (IN(4)) {
        pg8::Gemm g{F.MIX, F.WOUT_T, MROWS, 2048, 2048}; pg8::SplitOrder S; S.init(2048, F.G, bx);
        pg8::EpiResid<0> E{F.XN, (bf16*)(ws + WS_SLAB4), (float*)(ws + WS_SS)};
        pg8::gemm_phase<pg8::EpiResid<0>, pg8::SplitOrder, PG8_ALIGN, PG8_SP2>(F.lds, g, S, E);
        if (BOTH(4)) GRID_BAR();
    }
    if (IN(5)) { sample_rows_reduce(F, (const bf16*)(ws + WS_SLAB4), (float*)(ws + WS_SS)); if (BOTH(5)) GRID_BAR(); }
    if (IN(6)) {
        pg8::Gemm g{F.XN, F.WFI_T, MROWS, 11264, 2048}; pg8::HalfTailOrder S; S.init(MROWS, 11264, 2048, F.G, bx);
        pg8::EpiSwiglu E{F.ACT, 5632, (const float*)(ws + WS_SS)};
        pg8::gemm_phase<pg8::EpiSwiglu, pg8::HalfTailOrder, PG8_ALIGN, PG8_SP2>(F.lds, g, S, E);
        if (BOTH(6)) GRID_BAR();
    }
    if (IN(7)) {
        pg8::Gemm g{F.ACT, F.WFO_T, MROWS, 2048, 5632}; pg8::SplitOrder S; S.init(5632, F.G, bx);
        pg8::EpiResid<1> E{F.XN, (bf16*)(ws + WS_SLAB7), nullptr};
        pg8::gemm_phase<pg8::EpiResid<1>, pg8::SplitOrder, PG8_ALIGN, PG8_SP2>(F.lds, g, S, E);
        if (BOTH(7)) GRID_BAR();
    }
    if (IN(8)) final_norm(F, (const bf16*)(ws + WS_SLAB7));
#undef IN
#undef BOTH
}

extern "C" void kernel_launch(void* const* d_in, const int* in_sizes, int n_in, void* d_out, int out_size, void* d_ws, size_t ws_size, hipStream_t stream) {
    static int grid = 0;
    if (grid == 0) {
        if (n_in != 23 || ws_size < WS_END) { fprintf(stderr, "kernel_launch: expected 23 inputs and >= %zu bytes of workspace (got %d, %zu)\n", (size_t)WS_END, n_in, ws_size); grid = -1; return; }
        int dev = 0, cus = 0, per_cu = 0;
        if (hipGetDevice(&dev) != hipSuccess || hipDeviceGetAttribute(&cus, hipDeviceAttributeMultiprocessorCount, dev) != hipSuccess) { grid = -1; return; }
        if (hipFuncSetAttribute((const void*)mk_fwd, hipFuncAttributeMaxDynamicSharedMemorySize, LDS_BYTES) != hipSuccess) { fprintf(stderr, "kernel_launch: hipFuncSetAttribute failed\n"); grid = -1; return; }
        if (hipOccupancyMaxActiveBlocksPerMultiprocessor(&per_cu, (const void*)mk_fwd, NWAVES * 64, LDS_BYTES) != hipSuccess || per_cu < 1) { fprintf(stderr, "kernel_launch: occupancy query says %d blocks per CU\n", per_cu); grid = -1; (void)hipGetLastError(); return; }
        grid = cus;
        if (cus != 256) fprintf(stderr, "kernel_launch: built for a 256-CU device (static unit orders, split-K slices); this device reports %d CUs: the output will be wrong\n", cus);
    }
    if (grid < 0) return;
    if (hipMemsetAsync((char*)d_ws + WS_CTL, 0, CTL_ZERO_BYTES, stream) != hipSuccess) return;
    Args a{};
    for (int i = 0; i < 23; ++i) a.in[i] = (const float*)d_in[i];
    a.out = (float*)d_out; a.ws = (unsigned char*)d_ws;
    for (int li = 0; li < N_LAUNCHES; ++li) {
        a.ph_lo = (N_LAUNCHES == 1) ? 0 : li; a.ph_hi = (N_LAUNCHES == 1) ? N_PHASES : li + 1; a.li = li;
        void* kargs[] = {&a};
        hipError_t le = hipLaunchCooperativeKernel((const void*)mk_fwd, dim3(grid), dim3(NWAVES * 64), kargs, LDS_BYTES, stream);
        if (le != hipSuccess) { fprintf(stderr, "kernel_launch: launch %d failed: %s\n", li, hipGetErrorName(le)); break; }
    }
}
```

```cpp
#include <hip/hip_runtime.h>
#include <cstdio>
#include <cstdint>
#include <math.h>
#ifndef MK_N_LAUNCHES
#define MK_N_LAUNCHES 1
#endif
constexpr int N_LAUNCHES = MK_N_LAUNCHES;
constexpr int N_PHASES = 9;
constexpr int NWAVES = 8;
constexpr int MROWS = 9216;
constexpr size_t MiB = 1u << 20;
constexpr size_t WS_CTL = 0, CTL_ZERO_BYTES = 72 * 1024;
constexpr size_t WS_PAR = 1 * MiB;
constexpr size_t WS_WIN = 4 * MiB, WS_WGLU = 24 * MiB, WS_WOUT = 26 * MiB, WS_WFI = 34 * MiB, WS_WFO = 78 * MiB;
constexpr size_t WS_XN = 100 * MiB, WS_MIX = 136 * MiB, WS_YS5 = 172 * MiB;
constexpr size_t WS_U = 190 * MiB, WS_Q = 208 * MiB, WS_K = 226 * MiB, WS_V = 244 * MiB, WS_G = 262 * MiB, WS_O = 280 * MiB;
constexpr size_t WS_ACT = 190 * MiB;
constexpr size_t WS_SLAB4 = 190 * MiB;
constexpr size_t WS_SLAB7 = 4 * MiB;
constexpr size_t WS_S5L = 298 * MiB, WS_S5H = 306 * MiB, WS_S5G = 310 * MiB;
constexpr size_t WS_END = 314 * MiB;
constexpr int CW_BAR = 4096;
constexpr size_t WS_SS = 32 * 1024;
constexpr int LDS_BYTES = 147456, LDSCTL_OFF = 139264, MISC_OFF = LDSCTL_OFF + 320;
#ifndef PG8_SP2
#define PG8_SP2 true
#endif
#ifndef PG8_ALIGN
#define PG8_ALIGN true
#endif
namespace pg8 {
#define PG8_LAS __attribute__((address_space(3)))
typedef unsigned short bf16_t;
typedef short bf16x8 __attribute__((ext_vector_type(8)));
typedef float f32x4 __attribute__((ext_vector_type(4)));
typedef unsigned u32x4 __attribute__((ext_vector_type(4)));
constexpr int BM = 256, BK = 64, HALF = 128, HTB = HALF * BK * 2  , STAGE_BYTES = 8 * HTB, NXCD = 8, WGM = 8;

__host__ __device__ __forceinline__ int lds_byte(int r, int c) { const int st = (r >> 4) * 2 + (c >> 5), rr = r & 15, cc = c & 31, ob = rr * 64 + cc * 2; return st * 1024 + (ob ^ (((ob >> 9) & 1) << 5)); }
__host__ __device__ __forceinline__ void stage_rc(int b, int& R, int& C) { const int st = b / 1024, sb = b % 1024, swz = sb ^ (((sb >> 9) & 1) << 5); R = (st >> 1) * 16 + swz / 64; C = (st & 1) * 32 + (swz % 64) / 2; }
__host__ __device__ __forceinline__ int perm32(int rho) { const int n = rho >> 4, i = rho & 15; return 8 * (i >> 2) + 4 * n + (i & 3); }

struct Unit { int pm, pn, kt0, nt, sp, hm, roff; };
struct Gemm { const bf16_t* A; const bf16_t* Bt; int M, N, K; };

struct StaticOrder {
    int nM, nN, nwg, G, c, ntk;
    __host__ __device__ __forceinline__ void init(int M, int N, int K, int G_, int c_) { nM = M / BM; nN = N / BM; nwg = nM * nN; G = G_; c = c_; ntk = K / BK; }
    __host__ __device__ __forceinline__ bool next(int i, Unit& u) const { return map((long)i * G + c, u); }
    __host__ __device__ __forceinline__ bool map(const long L, Unit& u) const {
        if (L >= nwg) return false;
        u.kt0 = 0; u.nt = ntk; u.sp = -1; u.hm = 0; u.roff = 0;
        int wgid = (int)L; { const int q = nwg / NXCD, r = nwg % NXCD, xcd = wgid % NXCD, off = wgid / NXCD; wgid = (xcd < r ? xcd * (q + 1) : r * (q + 1) + (xcd - r) * q) + off; }
        const int nig = WGM * nN, gid = wgid / nig, fm = gid * WGM, gsz = (nM - fm) < WGM ? (nM - fm) : WGM;
        u.pm = fm + ((wgid % nig) % gsz); u.pn = (wgid % nig) / gsz; return true;
    }
    __device__ __forceinline__ void a_ready(const Unit&) const {}
    __device__ __forceinline__ void done(const Unit&) const {}
};

struct HalfTailOrder {
    StaticOrder so; int R, T;
    __host__ __device__ __forceinline__ void init(int M, int N, int K, int G_, int c_) { so.init(M, N, K, G_, c_); R = so.nwg / G_; T = so.nwg - R * G_; }
    __host__ __device__ __forceinline__ bool next(int i, Unit& u) const {
        const bool halves = (i == R) && (2 * T <= so.G);
        if (i > R || (halves && so.c >= 2 * T)) return false;
        const long L = halves ? (long)R * so.G + (so.c >> 1) : (long)i * so.G + so.c;
        const bool ok = so.map(L, u);
        u.hm = halves ? 1 : 0; u.roff = halves ? 128 * (so.c & 1) : 0;
        return ok;
    }
    __device__ __forceinline__ void a_ready(const Unit&) const {}
    __device__ __forceinline__ void done(const Unit&) const {}
};

struct SplitOrder {
    StaticOrder so; int c, ntk;
    __host__ __device__ __forceinline__ void init(int K, int G_, int c_) { so.init(8192, 2048, K, G_, c_); c = c_; ntk = K / BK; }
    __host__ __device__ __forceinline__ bool next(int i, Unit& u) const {
        if (i == 0) return so.next(0, u);
        if (i > 1) return false;
        if (ntk == 32) {
            if (c >= 128) return false;
            const int s = c & 3, ui = c >> 2;
            u.pm = 32 + (ui >> 3); u.pn = ui & 7; u.sp = s; u.hm = 0; u.roff = 0; u.kt0 = 8 * s; u.nt = 8;
            return true;
        }
        const int s = c & 7, ui = c >> 3;
        u.pm = 32 + (ui >> 3); u.pn = ui & 7; u.sp = s; u.hm = 0; u.roff = 0;
        { u.kt0 = 22 * (s >> 1) + 12 * (s & 1); u.nt = (s & 1) ? 10 : 12; }
        return true;
    }
    __device__ __forceinline__ void a_ready(const Unit&) const {}
    __device__ __forceinline__ void done(const Unit&) const {}
};

typedef float cvf32x2_t __attribute__((ext_vector_type(2))); typedef __bf16 cvbf16x2_t __attribute__((ext_vector_type(2)));
__device__ __forceinline__ unsigned cvt_pk_bf16(float lo, float hi) { const cvf32x2_t v = {lo, hi}; const cvbf16x2_t b = __builtin_convertvector(v, cvbf16x2_t); return __builtin_bit_cast(unsigned, b); }
typedef unsigned u32x2 __attribute__((ext_vector_type(2)));
__device__ __forceinline__ float bf_lo(unsigned w) { return __uint_as_float(w << 16); }
__device__ __forceinline__ float bf_hi(unsigned w) { return __uint_as_float(w & 0xffff0000u); }
__device__ __forceinline__ float fsigmoid(float x) { return __builtin_amdgcn_rcpf(1.f + __expf(-x)); }
__device__ __forceinline__ u32x4 pack8(const f32x4 a, const f32x4 b) { u32x4 w; w.x = cvt_pk_bf16(a[0], a[1]); w.y = cvt_pk_bf16(a[2], a[3]); w.z = cvt_pk_bf16(b[0], b[1]); w.w = cvt_pk_bf16(b[2], b[3]); return w; }

struct EpiProj {
    static constexpr bool PERM = true, AFTER_DRAIN = false;
    __device__ __forceinline__ void init(f32x4 (&acc)[2][2][4][2], const Unit&, int, int, int, int) const {
#pragma unroll
        for (int a = 0; a < 2; ++a)
#pragma unroll
            for (int b = 0; b < 2; ++b)
#pragma unroll
                for (int m = 0; m < 4; ++m)
#pragma unroll
                    for (int n = 0; n < 2; ++n) acc[a][b][m][n] = (f32x4){0.f, 0.f, 0.f, 0.f};
    }
    bf16_t* base5;
    static constexpr size_t KSTRIDE = (size_t)18 * 1024 * 1024 / 2;
    const float *ropec, *ropes;
    const float* ss0;
    __device__ __forceinline__ void operator()(const f32x4 (&acc)[2][2][4][2], const Unit& u, int wr, int wc, int fr, int fq) const {
        const int kind = u.pn >> 2, sub = u.pn & 3;
        const int row0 = u.pm * BM + wr * 64 + fr;
        float srv[2][4];
#pragma unroll
        for (int ai = 0; ai < 2; ++ai)
#pragma unroll
            for (int m = 0; m < 4; ++m) srv[ai][m] = ss0[row0 + ai * HALF + m * 16];
        if (kind == 1 || kind == 2) {
            bf16_t* dst = base5 + (size_t)kind * KSTRIDE;
            const int head = 2 * sub + (wc >> 1), j0 = 32 * (wc & 1) + 8 * fq;
            const float l2g = __log2f(1.f - exp2f(-5.f - (float)head));
            const float ksc = (kind == 2) ? 0.08838834764831845f : 1.f;
#pragma unroll
            for (int ai = 0; ai < 2; ++ai)
#pragma unroll
                for (int m = 0; m < 4; ++m) {
                    const int r = row0 + ai * HALF + m * 16;
                    int pi; float sc;
                    if (r < 8192) { const int t = r & 2047; pi = t; const int tt = t & 127; sc = exp2f(l2g * (kind == 1 ? (float)(tt - 127) : (float)(127 - tt))) * ksc; }
                    else { pi = 2048 + (r & 7); sc = ksc; }
                    const f32x4 c0 = *(const f32x4*)(ropec + pi * 64 + j0), c1 = *(const f32x4*)(ropec + pi * 64 + j0 + 4);
                    const f32x4 s0 = *(const f32x4*)(ropes + pi * 64 + j0), s1 = *(const f32x4*)(ropes + pi * 64 + j0 + 4);
                    sc *= rsqrtf(srv[ai][m] * (1.f / 2048.f) + 1e-6f);
                    const f32x4 x1a = acc[ai][0][m][0], x1b = acc[ai][0][m][1], x2a = acc[ai][1][m][0], x2b = acc[ai][1][m][1];
                    const f32x4 r1a = (x1a * c0 - x2a * s0) * sc, r1b = (x1b * c1 - x2b * s1) * sc;
                    const f32x4 r2a = (x1a * s0 + x2a * c0) * sc, r2b = (x1b * s1 + x2b * c1) * sc;
                    bf16_t* rowp = dst + (size_t)r * 1024 + head * 128 + j0;
                    *(u32x4*)(rowp) = pack8(r1a, r1b);
                    *(u32x4*)(rowp + 64) = pack8(r2a, r2b);
                }
        } else {
            bf16_t* dst = base5 + (size_t)kind * KSTRIDE;
            const int col0 = 256 * sub + wc * 32 + 8 * fq;
#pragma unroll
            for (int ai = 0; ai < 2; ++ai)
#pragma unroll
                for (int m = 0; m < 4; ++m) {
                    bf16_t* rowp = dst + (size_t)(row0 + ai * HALF + m * 16) * 1024 + col0;
                    const float sr = rsqrtf(srv[ai][m] * (1.f / 2048.f) + 1e-6f);
#pragma unroll
                    for (int bj = 0; bj < 2; ++bj) {
                        f32x4 v0 = acc[ai][bj][m][0] * sr, v1 = acc[ai][bj][m][1] * sr;
                        if (kind == 4) {
#pragma unroll
                            for (int i = 0; i < 4; ++i) { v0[i] = v0[i] * fsigmoid(v0[i]); v1[i] = v1[i] * fsigmoid(v1[i]); }
                        }
                        *(u32x4*)(rowp + bj * HALF) = pack8(v0, v1);
                    }
                }
        }
    }
};

struct EpiGlu {
    static constexpr bool PERM = true, AFTER_DRAIN = false;
    __device__ __forceinline__ void init(f32x4 (&acc)[2][2][4][2], const Unit&, int, int, int, int) const {
#pragma unroll
        for (int a = 0; a < 2; ++a)
#pragma unroll
            for (int b = 0; b < 2; ++b)
#pragma unroll
                for (int m = 0; m < 4; ++m)
#pragma unroll
                    for (int n = 0; n < 2; ++n) acc[a][b][m][n] = (f32x4){0.f, 0.f, 0.f, 0.f};
    }
    const bf16_t* Y; bf16_t* O; const float* bias;
    __device__ __forceinline__ void operator()(const f32x4 (&acc)[2][2][4][2], const Unit& u, int wr, int wc, int fr, int fq) const {
        const int row0 = u.pm * BM + wr * 64 + fr, col0 = u.pn * BM + wc * 32 + 8 * fq;
        f32x4 bv[2][2];
#pragma unroll
        for (int bj = 0; bj < 2; ++bj)
#pragma unroll
            for (int n = 0; n < 2; ++n) bv[bj][n] = *(const f32x4*)(bias + col0 + bj * HALF + 4 * n);
#pragma unroll
        for (int ai = 0; ai < 2; ++ai)
#pragma unroll
            for (int m = 0; m < 4; ++m) {
                const size_t r = (size_t)(row0 + ai * HALF + m * 16);
#pragma unroll
                for (int bj = 0; bj < 2; ++bj) {
                    const u32x4 yw = *(const u32x4*)(Y + r * 1024 + col0 + bj * HALF);
                    const f32x4 z0 = acc[ai][bj][m][0] + bv[bj][0], z1 = acc[ai][bj][m][1] + bv[bj][1];
                    f32x4 o0, o1;
                    o0[0] = bf_lo(yw.x) * fsigmoid(z0[0]); o0[1] = bf_hi(yw.x) * fsigmoid(z0[1]); o0[2] = bf_lo(yw.y) * fsigmoid(z0[2]); o0[3] = bf_hi(yw.y) * fsigmoid(z0[3]);
                    o1[0] = bf_lo(yw.z) * fsigmoid(z1[0]); o1[1] = bf_hi(yw.z) * fsigmoid(z1[1]); o1[2] = bf_lo(yw.w) * fsigmoid(z1[2]); o1[3] = bf_hi(yw.w) * fsigmoid(z1[3]);
                    *(u32x4*)(O + r * 2048 + col0 + bj * HALF) = pack8(o0, o1);
                }
            }
    }
};

struct EpiSwiglu {
    static constexpr bool PERM = true, AFTER_DRAIN = false;
    __device__ __forceinline__ void init(f32x4 (&acc)[2][2][4][2], const Unit&, int, int, int, int) const {
#pragma unroll
        for (int a = 0; a < 2; ++a)
#pragma unroll
            for (int b = 0; b < 2; ++b)
#pragma unroll
                for (int m = 0; m < 4; ++m)
#pragma unroll
                    for (int n = 0; n < 2; ++n) acc[a][b][m][n] = (f32x4){0.f, 0.f, 0.f, 0.f};
    }
    bf16_t* O; int ldo; const float* ss;
    __device__ __forceinline__ void operator()(const f32x4 (&acc)[2][2][4][2], const Unit& u, int wr, int wc, int fr, int fq) const {
        const int row0 = u.pm * BM + u.roff + wr * 64 + fr, col0 = u.pn * HALF + wc * 32 + 8 * fq;
        float srv[2][4];
#pragma unroll
        for (int ai = 0; ai < 2; ++ai)
#pragma unroll
            for (int m = 0; m < 4; ++m) srv[ai][m] = (ai == 1 && u.hm) ? 1.f : ss[row0 + ai * HALF + m * 16];
#pragma unroll
        for (int ai = 0; ai < 2; ++ai)
#pragma unroll
            for (int m = 0; m < 4; ++m) {
                if (ai == 1 && u.hm) continue;
                const float sr = rsqrtf(srv[ai][m] * (1.f / 2048.f) + 1e-6f);
                const f32x4 g0 = acc[ai][0][m][0] * sr, g1 = acc[ai][0][m][1] * sr, u0 = acc[ai][1][m][0] * sr, u1 = acc[ai][1][m][1] * sr;
                f32x4 a0, a1;
#pragma unroll
                for (int i = 0; i < 4; ++i) { a0[i] = g0[i] * fsigmoid(g0[i]) * u0[i]; a1[i] = g1[i] * fsigmoid(g1[i]) * u1[i]; }
                *(u32x4*)(O + (size_t)(row0 + ai * HALF + m * 16) * ldo + col0) = pack8(a0, a1);
            }
    }
};

template <int MODE> struct EpiResid {
    static constexpr bool PERM = true, AFTER_DRAIN = false;
    bf16_t* xb; bf16_t* slab; float* ss;
    __device__ __forceinline__ void init(f32x4 (&acc)[2][2][4][2], const Unit& u, int wr, int wc, int fr, int fq) const {
        const int row0 = u.pm * BM + wr * 64 + fr, col0 = u.pn * BM + wc * 32 + 8 * fq;
#pragma unroll
        for (int ai = 0; ai < 2; ++ai)
#pragma unroll
            for (int m = 0; m < 4; ++m) {
                const bf16_t* xr = xb + (size_t)(row0 + ai * HALF + m * 16) * 2048 + col0;
#pragma unroll
                for (int bj = 0; bj < 2; ++bj) {
                    if (u.sp >= 0) { acc[ai][bj][m][0] = (f32x4){0.f, 0.f, 0.f, 0.f}; acc[ai][bj][m][1] = (f32x4){0.f, 0.f, 0.f, 0.f}; }
                    else { const u32x4 w = *(const u32x4*)(xr + bj * HALF);
                        acc[ai][bj][m][0] = (f32x4){bf_lo(w.x), bf_hi(w.x), bf_lo(w.y), bf_hi(w.y)}; acc[ai][bj][m][1] = (f32x4){bf_lo(w.z), bf_hi(w.z), bf_lo(w.w), bf_hi(w.w)}; }
                }
            }
    }
    __device__ __forceinline__ void operator()(const f32x4 (&acc)[2][2][4][2], const Unit& u, int wr, int wc, int fr, int fq) const {
        const int row0 = u.pm * BM + wr * 64 + fr, col0 = u.pn * BM + wc * 32 + 8 * fq;
        if (u.sp >= 0) {
            bf16_t* sb = slab + ((size_t)u.sp * 1024 + (size_t)(row0 - 8192)) * 2048 + col0;
#pragma unroll
            for (int ai = 0; ai < 2; ++ai)
#pragma unroll
                for (int m = 0; m < 4; ++m)
#pragma unroll
                    for (int bj = 0; bj < 2; ++bj) *(u32x4*)(sb + (size_t)(ai * HALF + m * 16) * 2048 + bj * HALF) = pack8(acc[ai][bj][m][0], acc[ai][bj][m][1]);
            return;
        }
#pragma unroll
        for (int ai = 0; ai < 2; ++ai)
#pragma unroll
            for (int m = 0; m < 4; ++m) {
                const int r = row0 + ai * HALF + m * 16;
                bf16_t* xr = xb + (size_t)r * 2048 + col0;
                float q = 0.f;
#pragma unroll
                for (int bj = 0; bj < 2; ++bj) { const f32x4 v0 = acc[ai][bj][m][0], v1 = acc[ai][bj][m][1];
                    q += ((v0[0] * v0[0] + v0[1] * v0[1]) + (v0[2] * v0[2] + v0[3] * v0[3])) + ((v1[0] * v1[0] + v1[1] * v1[1]) + (v1[2] * v1[2] + v1[3] * v1[3]));
                    *(u32x4*)(xr + bj * HALF) = pack8(v0, v1); }
                if (MODE == 0) { q += __shfl_xor(q, 16); q += __shfl_xor(q, 32); if (fq == 0) atomicAdd(ss + r, q); }
            }
    }
};

template <class Epi, class Sched, bool ALIGN_EPI = false, bool SP2 = false>
__device__ __forceinline__ void gemm_phase(PG8_LAS unsigned char* lds, const Gemm g, const Sched& S, const Epi& E) {
    const int tid = threadIdx.x, wid = __builtin_amdgcn_readfirstlane(tid >> 6), lane = tid & 63, wr = wid >> 2, wc = wid & 3, fr = lane & 15, fq = lane >> 4;
    const int K = g.K;
    unsigned voffA[2], voffB[2];
#pragma unroll
    for (int i = 0; i < 2; ++i) { int R, C; stage_rc(tid * 16 + i * 8192, R, C); const int Rb = Epi::PERM ? ((R & ~31) + perm32(R & 31)) : R;
        voffA[i] = (unsigned)(R * K + C) * 2u; voffB[i] = (unsigned)(Rb * K + C) * 2u; }
    const size_t kstep = (size_t)(BK * 2);
    const size_t hstep = (size_t)HALF * K * 2;
    const size_t tstep = 2 * hstep;
    const unsigned ldsw = (unsigned)wid * 1024u;
    const int aoff = lds_byte(wr * 64 + fr, fq * 8), boff = lds_byte(wc * 32 + fr, fq * 8);
#define PG8_SA(b, h) (((b) * 2 + (h)) * HTB)
#define PG8_SB(b, h) ((4 + (b) * 2 + (h)) * HTB)
#define PG8_STAGE(bufoff, gbase, voff) do { _Pragma("unroll") for (int _i = 0; _i < 2; ++_i) \
        __builtin_amdgcn_global_load_lds((const unsigned*)((const char*)(gbase) + (voff)[_i]), (PG8_LAS unsigned*)(lds + (bufoff) + ldsw + _i * 8192), 16, 0, 0); } while (0)
#define PG8_LDA(dst, b, h) do { _Pragma("unroll") for (int m = 0; m < 4; ++m) _Pragma("unroll") for (int k = 0; k < 2; ++k) dst[m][k] = *(const PG8_LAS bf16x8*)(lds + PG8_SA(b, h) + aoff + m * 2048 + k * 1024); } while (0)
#define PG8_LDB(dst, b, h) do { _Pragma("unroll") for (int n = 0; n < 2; ++n) _Pragma("unroll") for (int k = 0; k < 2; ++k) dst[n][k] = *(const PG8_LAS bf16x8*)(lds + PG8_SB(b, h) + boff + n * 2048 + k * 1024); } while (0)
#define PG8_MMA(ai, bj, At, Bt) do { __builtin_amdgcn_s_setprio(1); _Pragma("unroll") for (int m = 0; m < 4; ++m) _Pragma("unroll") for (int n = 0; n < 2; ++n) _Pragma("unroll") for (int k = 0; k < 2; ++k) \
        acc[ai][bj][m][n] = __builtin_amdgcn_mfma_f32_16x16x32_bf16(Bt[n][k], At[m][k], acc[ai][bj][m][n], 0, 0, 0); __builtin_amdgcn_s_setprio(0); } while (0)
#define PG8_WAIT_V(n) asm volatile("s_waitcnt vmcnt(" #n ")" ::: "memory")
#define PG8_WAIT_L(n) asm volatile("s_waitcnt lgkmcnt(" #n ")" ::: "memory")
#define PG8_BAR __builtin_amdgcn_s_barrier()
#define PG8_SCHED __builtin_amdgcn_sched_barrier(0)
    Unit cur, nxt; int ui = 0;
    if (!S.next(0, cur)) return;
    f32x4 acc[2][2][4][2];
    E.init(acc, cur, wr, wc, fr, fq);
    bf16x8 At[4][2], B0[2][2], B1[2][2];
    const char* cA = (const char*)g.A + (size_t)cur.pm * tstep + (size_t)cur.kt0 * kstep + (size_t)cur.roff * K * 2; const char* cB = (const char*)g.Bt + (size_t)cur.pn * tstep + (size_t)cur.kt0 * kstep;
    S.a_ready(cur);
    if constexpr (SP2) {
        PG8_STAGE(PG8_SB(0, 0), cB, voffB); PG8_STAGE(PG8_SB(0, 1), cB + hstep, voffB); PG8_STAGE(PG8_SA(0, 0), cA, voffA); PG8_STAGE(PG8_SA(0, 1), cA + hstep, voffA);
        if (wr == 1) PG8_BAR;
        PG8_WAIT_V(2); PG8_BAR;
        PG8_STAGE(PG8_SB(1, 0), cB + kstep, voffB); PG8_STAGE(PG8_SA(1, 0), cA + kstep, voffA); PG8_STAGE(PG8_SB(1, 1), cB + hstep + kstep, voffB);
        PG8_WAIT_V(6); PG8_BAR;
    } else {
        PG8_STAGE(PG8_SB(0, 0), cB, voffB); PG8_STAGE(PG8_SA(0, 0), cA, voffA); PG8_STAGE(PG8_SB(0, 1), cB + hstep, voffB); PG8_STAGE(PG8_SA(0, 1), cA + hstep, voffA);
        if (wr == 1) PG8_BAR;
        PG8_WAIT_V(4); PG8_BAR;
        PG8_STAGE(PG8_SB(1, 0), cB + kstep, voffB); PG8_STAGE(PG8_SA(1, 0), cA + kstep, voffA); PG8_STAGE(PG8_SB(1, 1), cB + hstep + kstep, voffB);
        PG8_WAIT_V(6); PG8_BAR;
    }
    for (;;) {
        const bool has_next = S.next(ui + 1, nxt);
        const char* nA = has_next ? (const char*)g.A + (size_t)nxt.pm * tstep + (size_t)nxt.kt0 * kstep + (size_t)nxt.roff * K * 2 : cA; const char* nB = has_next ? (const char*)g.Bt + (size_t)nxt.pn * tstep + (size_t)nxt.kt0 * kstep : cB;
        const int nt = cur.nt; const bool full = (cur.hm == 0);
        for (int t = 0; t < nt; t += 2) {
            const bool last = (t == nt - 2);
            const char* a1 = cA + (size_t)(t + 1) * kstep;
            const char* a2 = last ? nA : cA + (size_t)(t + 2) * kstep; const char* b2 = last ? nB : cB + (size_t)(t + 2) * kstep;
            const char* a3 = a2 + kstep; const char* b3 = b2 + kstep;
            if (last && has_next) S.a_ready(nxt);
            if constexpr (SP2) {
            PG8_LDB(B0, 0, 0); PG8_LDB(B1, 0, 1); PG8_SCHED; PG8_LDA(At, 0, 0); PG8_STAGE(PG8_SA(1, 1), a1 + hstep, voffA);
            PG8_WAIT_V(8); PG8_WAIT_L(0); PG8_BAR; PG8_MMA(0, 0, At, B0); PG8_MMA(0, 1, At, B1); PG8_BAR; PG8_SCHED;
            if (full) PG8_LDA(At, 0, 1); PG8_STAGE(PG8_SB(0, 0), b2, voffB); PG8_STAGE(PG8_SB(0, 1), b2 + hstep, voffB); PG8_STAGE(PG8_SA(0, 0), a2, voffA);
            PG8_WAIT_V(8); PG8_WAIT_L(0); PG8_BAR; if (full) { PG8_MMA(1, 0, At, B0); PG8_MMA(1, 1, At, B1); } PG8_BAR; PG8_SCHED;
            PG8_LDB(B0, 1, 0); PG8_LDB(B1, 1, 1); PG8_SCHED; PG8_LDA(At, 1, 0); PG8_STAGE(PG8_SA(0, 1), a2 + hstep, voffA);
            PG8_WAIT_V(8); PG8_WAIT_L(0); PG8_BAR; PG8_MMA(0, 0, At, B0); PG8_MMA(0, 1, At, B1); PG8_BAR; PG8_SCHED;
            if (full) PG8_LDA(At, 1, 1); PG8_STAGE(PG8_SB(1, 0), b3, voffB); PG8_STAGE(PG8_SB(1, 1), b3 + hstep, voffB); PG8_STAGE(PG8_SA(1, 0), a3, voffA);
            PG8_WAIT_V(8); PG8_WAIT_L(0); PG8_BAR; if (full) { PG8_MMA(1, 0, At, B0); PG8_MMA(1, 1, At, B1); } PG8_BAR; PG8_SCHED;
            } else {
            PG8_LDB(B0, 0, 0); PG8_SCHED; PG8_LDA(At, 0, 0); PG8_STAGE(PG8_SA(1, 1), a1 + hstep, voffA);
            PG8_WAIT_L(8); PG8_BAR; PG8_WAIT_L(0); PG8_MMA(0, 0, At, B0); PG8_BAR; PG8_SCHED;
            PG8_LDB(B1, 0, 1); PG8_STAGE(PG8_SB(0, 0), b2, voffB);
            PG8_BAR; PG8_WAIT_L(0); PG8_MMA(0, 1, At, B1); PG8_BAR;
            PG8_LDA(At, 0, 1); PG8_STAGE(PG8_SA(0, 0), a2, voffA);
            PG8_BAR; PG8_WAIT_L(0); PG8_MMA(1, 0, At, B0); PG8_BAR; PG8_SCHED;
            PG8_STAGE(PG8_SB(0, 1), b2 + hstep, voffB);
            PG8_WAIT_V(6); PG8_BAR; PG8_MMA(1, 1, At, B1); PG8_BAR;
            PG8_LDB(B0, 1, 0); PG8_SCHED; PG8_LDA(At, 1, 0); PG8_STAGE(PG8_SA(0, 1), a2 + hstep, voffA);
            PG8_WAIT_L(8); PG8_BAR; PG8_WAIT_L(0); PG8_MMA(0, 0, At, B0); PG8_BAR; PG8_SCHED;
            PG8_LDB(B1, 1, 1); PG8_STAGE(PG8_SB(1, 0), b3, voffB);
            PG8_BAR; PG8_WAIT_L(0); PG8_MMA(0, 1, At, B1); PG8_BAR;
            PG8_LDA(At, 1, 1); PG8_STAGE(PG8_SA(1, 0), a3, voffA);
            PG8_BAR; PG8_WAIT_L(0); PG8_MMA(1, 0, At, B0); PG8_BAR; PG8_SCHED;
            PG8_STAGE(PG8_SB(1, 1), b3 + hstep, voffB);
            PG8_WAIT_V(6); PG8_BAR; PG8_MMA(1, 1, At, B1); PG8_BAR;
            }
        }
        if constexpr (ALIGN_EPI) { if (wr == 0) PG8_BAR; }
        if constexpr (!Epi::AFTER_DRAIN) { E(acc, cur, wr, wc, fr, fq); S.done(cur); }
        if (!has_next) break;
        E.init(acc, nxt, wr, wc, fr, fq);
        cur = nxt; cA = nA; cB = nB; ++ui;
        if constexpr (ALIGN_EPI) { if (wr == 1) PG8_BAR; }
    }
    PG8_WAIT_V(0);
    if constexpr (!ALIGN_EPI) { if (wr == 0) PG8_BAR; }
    PG8_BAR;
    if constexpr (Epi::AFTER_DRAIN) { E.fused(acc, cur, wr, wc, fr, fq, lds, wid, lane); S.done(cur); }
#undef PG8_SA
#undef PG8_SB
#undef PG8_STAGE
#undef PG8_LDA
#undef PG8_LDB
#undef PG8_MMA
#undef PG8_WAIT_V
#undef PG8_WAIT_L
#undef PG8_BAR
#undef PG8_SCHED
}
}
#define GAS __attribute__((address_space(1)))
#define LAS __attribute__((address_space(3)))
typedef unsigned short bf16;
typedef unsigned v4u __attribute__((ext_vector_type(4)));
typedef float f32x4 __attribute__((ext_vector_type(4)));
typedef short bf16x8 __attribute__((ext_vector_type(8)));
typedef GAS unsigned gu32;
typedef GAS unsigned long long gu64;
#define RLX_AGENT __ATOMIC_RELAXED, __HIP_MEMORY_SCOPE_AGENT
#define LDS_WAIT() asm volatile("s_waitcnt lgkmcnt(0)" ::: "memory")
#define VM_WAIT() asm volatile("s_waitcnt vmcnt(0)" ::: "memory")
__device__ __forceinline__ unsigned long long rt() { return __builtin_amdgcn_s_memrealtime(); }
__device__ __forceinline__ unsigned f2bf(float f) { unsigned u = __builtin_bit_cast(unsigned, f); return (u + 0x7fffu + ((u >> 16) & 1u)) >> 16; }
__device__ __forceinline__ unsigned pk2(float lo, float hi) { return f2bf(lo) | (f2bf(hi) << 16); }

#define XB_TMO      128
#define XB_XCNT(j)  (256  + 64 * (j))
#define XB_XSUB(j)  (1280 + 64 * (j))
#define XB_XGEN(j)  (2304 + 64 * (j))
#define XB_TOP      3328
#define XB_TOPGEN   3392
#define XCD_BAR_WORDS 3456
#define XB_SPIN_CAP (1u << 18)

__device__ __forceinline__ unsigned xb_ld(unsigned* p)              { return __hip_atomic_load(p, __ATOMIC_RELAXED, __HIP_MEMORY_SCOPE_AGENT); }
__device__ __forceinline__ unsigned xb_add(unsigned* p, unsigned v) { return __hip_atomic_fetch_add(p, v, __ATOMIC_RELAXED, __HIP_MEMORY_SCOPE_AGENT); }
__device__ __forceinline__ unsigned xb_xcc_id() { return (unsigned)__builtin_amdgcn_s_getreg((3 << 11) | 20) & 0xFu; }
#define XB_SPIN(cond, bar) do { unsigned _sp = 0; while (cond) { __builtin_amdgcn_s_sleep(1); \
    if ((++_sp & 255u) == 0u) { if (xb_ld(&(bar)[XB_TMO])) break; if (_sp > XB_SPIN_CAP) { atomicAdd(&(bar)[XB_TMO], 1u); break; } } } } while (0)

struct XcdBarrier {
    unsigned* bar; unsigned x;
    volatile LAS unsigned* st;
};

__device__ __forceinline__ XcdBarrier xcd_barrier_post(unsigned* bar, volatile LAS unsigned* st) {
    XcdBarrier b; b.bar = bar; b.x = xb_xcc_id(); b.st = st;
    if (threadIdx.x == 0) (void)xb_add(&bar[XB_XCNT(b.x)], 1u);
    return b;
}
__device__ __forceinline__ void xcd_barrier_complete(unsigned* bar, unsigned x, unsigned& nloc, unsigned& nx) {
    const unsigned G = gridDim.x * gridDim.y * gridDim.z;
    unsigned sum, cnt, mine, sp = 0u;
    for (;;) {
        sum = 0u; cnt = 0u; mine = 0u;
#pragma unroll
        for (unsigned j = 0; j < 16; ++j) { const unsigned c = xb_ld(&bar[XB_XCNT(j)]); sum += c; cnt += (c > 0u) ? 1u : 0u; mine = (j == x) ? c : mine; }
        if (sum == G) break;
        __builtin_amdgcn_s_sleep(1);
        if ((++sp & 255u) == 0u) { if (xb_ld(&bar[XB_TMO])) break; if (sp > XB_SPIN_CAP) { atomicAdd(&bar[XB_TMO], 1u); break; } }
    }
    nloc = mine > 0u ? mine : 1u; nx = cnt > 0u ? cnt : 1u;
}

__device__ __forceinline__ void xcd_barrier(const XcdBarrier& b) {
    asm volatile("s_waitcnt vmcnt(0)" ::: "memory");
    __syncthreads();
    if (threadIdx.x == 0) {
        unsigned* bar = b.bar;
        __builtin_amdgcn_s_waitcnt(0);
        unsigned nloc = b.st[0], nx = b.st[1];
        if (nloc == 0u) { xcd_barrier_complete(bar, b.x, nloc, nx); b.st[0] = nloc; b.st[1] = nx; }
        const unsigned old = xb_add(&bar[XB_XSUB(b.x)], 1u);
        const unsigned gen = old / nloc;
        if (old + 1u == (gen + 1u) * nloc) {
            __builtin_amdgcn_fence(__ATOMIC_RELEASE, "agent");
            asm volatile("s_waitcnt vmcnt(0)" ::: "memory");
            const unsigned og = xb_add(&bar[XB_TOP], 1u);
            const unsigned tg = og / nx;
            if (og + 1u == (tg + 1u) * nx) xb_add(&bar[XB_TOPGEN], 1u);
            else XB_SPIN(xb_ld(&bar[XB_TOPGEN]) == tg, bar);
            __builtin_amdgcn_fence(__ATOMIC_ACQUIRE, "agent");
            xb_add(&bar[XB_XGEN(b.x)], 1u);
            asm volatile("s_waitcnt vmcnt(0)" ::: "memory");
        } else {
            XB_SPIN(xb_ld(&bar[XB_XGEN(b.x)]) == gen, bar);
            __builtin_amdgcn_fence(__ATOMIC_ACQUIRE, "agent");
            asm volatile("s_waitcnt vmcnt(0)" ::: "memory");
        }
    }
    __syncthreads();
}

typedef short s16x4 __attribute__((ext_vector_type(4)));
typedef float f32x2v __attribute__((ext_vector_type(2)));
typedef float f32x16 __attribute__((ext_vector_type(16)));
typedef unsigned u32x2v __attribute__((ext_vector_type(2)));

struct Frame {
    LAS unsigned char* lds;
    volatile LAS unsigned* MISC;
    gu32* ctl;
    int tid, lane, wave;
    int G;
    const float *x_prompt, *x_sample, *st_re, *st_im, *st_ret, *norm_mix, *w_in, *lam_re, *lam_im, *log_step, *b_re, *b_im, *c_re, *c_im, *s5_d, *w_glu, *b_glu, *gn_w, *w_out, *norm_ffn, *w_ffn_in, *w_ffn_out, *norm_final;
    float *Y, *o_s5re_p, *o_s5im_p, *o_ret_p, *o_s5re_s, *o_s5im_s, *o_ret_s;
    float *LBR, *LBI, *ROPEC, *ROPES, *SS0;
    bf16 *BB, *CMT;
    bf16 *WIN_T, *WGLU_T, *WOUT_T, *WFI_T, *WFO_T;
    bf16 *XN, *U, *Q, *Kb, *V, *Gt, *Ob, *YS5, *MIX, *ACT;
    bf16 *S5Lm, *S5Hm, *S5Gm;
};

__device__ __forceinline__ float wave_sum(float v) {
#pragma unroll
    for (int o = 1; o < 64; o <<= 1) v += __shfl_xor(v, o);
    return v;
}
__device__ __forceinline__ unsigned offb(unsigned row, unsigned ch) { return 256u * row + 16u * (ch ^ (((row & 3u) << 2) | ((row >> 2) & 3u))); }
typedef float cvf32x2 __attribute__((ext_vector_type(2))); typedef __bf16 cvbf16x2 __attribute__((ext_vector_type(2)));
__device__ __forceinline__ unsigned cvtpk(float lo, float hi) { const cvf32x2 v = {lo, hi}; const cvbf16x2 b = __builtin_convertvector(v, cvbf16x2); return __builtin_bit_cast(unsigned, b); }
__device__ __forceinline__ float bflo(unsigned w) { return __uint_as_float(w << 16); }
__device__ __forceinline__ float bfhi(unsigned w) { return __uint_as_float(w & 0xffff0000u); }
__device__ __forceinline__ bf16x8 tr_pair(LAS unsigned char* base, unsigned a0, unsigned a1) {
    const s16x4 lo = __builtin_amdgcn_ds_read_tr16_b64_v4i16((LAS s16x4*)(base + a0));
    const s16x4 hi = __builtin_amdgcn_ds_read_tr16_b64_v4i16((LAS s16x4*)(base + a1));
    return __builtin_shufflevector(lo, hi, 0, 1, 2, 3, 4, 5, 6, 7);
}

#define LDS_BARRIER() do { asm volatile("s_waitcnt lgkmcnt(0)" ::: "memory"); __builtin_amdgcn_s_barrier(); asm volatile("" ::: "memory"); } while (0)
template <int K, int N> __device__ __forceinline__ void p0_ld(const float* W, int kb, int nb, float (&r)[32], int lane, const float* kscale = nullptr) {
#pragma unroll
    for (int i = 0; i < 32; ++i) r[i] = __builtin_nontemporal_load(W + (size_t)(64 * kb + 2 * i + (lane >> 5)) * N + 32 * nb + (lane & 31));
    if (kscale) {
#pragma unroll
        for (int i = 0; i < 32; ++i) r[i] *= kscale[64 * kb + 2 * i + (lane >> 5)];
    }
}
template <int K> __device__ __forceinline__ void p0_st(bf16* WT, int kb, int drow0, const float (&r)[32], LAS float* scr, int lane) {
#pragma unroll
    for (int i = 0; i < 32; ++i) scr[(2 * i + (lane >> 5)) * 33 + (lane & 31)] = r[i];
    LDS_WAIT(); asm volatile("" ::: "memory");
    const int c = lane & 7;
#pragma unroll
    for (int j = 0; j < 4; ++j) { const int n = (lane >> 3) + 8 * j; const LAS float* s = scr + (8 * c) * 33 + n;
        v4u o; o.x = pk2(s[0 * 33], s[1 * 33]); o.y = pk2(s[2 * 33], s[3 * 33]); o.z = pk2(s[4 * 33], s[5 * 33]); o.w = pk2(s[6 * 33], s[7 * 33]);
        *(GAS v4u*)(WT + (size_t)(drow0 + n) * K + 64 * kb + 8 * c) = o; }
    LDS_WAIT(); asm volatile("" ::: "memory");
}
__device__ __forceinline__ int win_dest_row(int n0) {
    if (n0 < 1024 || n0 >= 3072) return n0;
    const int kind = n0 >> 10, rel = n0 & 1023, head = rel >> 7, bj = (rel >> 6) & 1, j = rel & 63;
    return 1024 * kind + 256 * (head >> 1) + 128 * bj + 64 * (head & 1) + j;
}
__device__ __forceinline__ int wfi_dest_row(int n0) {
    const int up = n0 >= 5632 ? 1 : 0, cc = n0 - up * 5632;
    return 256 * (cc >> 7) + 128 * up + (cc & 127);
}
__device__ __forceinline__ void rms_row_load(const float* xrow, f32x4 (&v)[8], int lane) {
    const GAS f32x4* xr = (const GAS f32x4*)xrow + lane;
#pragma unroll
    for (int j = 0; j < 8; ++j) v[j] = __builtin_nontemporal_load(xr + 64 * j);
}
__device__ __forceinline__ void rms_row_finish(const f32x4 (&v)[8], float* ssrow, bf16* orow, int lane) {
    float s = 0.f;
#pragma unroll
    for (int j = 0; j < 8; ++j) s += (v[j].x * v[j].x + v[j].y * v[j].y) + (v[j].z * v[j].z + v[j].w * v[j].w);
    s = wave_sum(s);
    if (lane == 0) *ssrow = s;
    GAS unsigned long long* o8 = (GAS unsigned long long*)orow + lane;
#pragma unroll
    for (int j = 0; j < 8; ++j) o8[64 * j] = (unsigned long long)pk2(v[j].x, v[j].y) | ((unsigned long long)pk2(v[j].z, v[j].w) << 32);
}
__device__ __forceinline__ const float* xrow_ptr(const Frame& F, int r) { return r < 8192 ? F.x_prompt + (size_t)r * 2048 : F.x_sample + (size_t)(r - 8192) * 2048; }

constexpr int I_IN = 32 * 160, I_GLU = 16 * 32, I_OUT = 32 * 64, I_FI = 32 * 352, I_FO = 88 * 64, NITEMS = I_IN + I_GLU + I_OUT + I_FI + I_FO;
constexpr int I_FO_P0 = 1792;
__device__ __forceinline__ void p0_item_load(const Frame& F, int it, float (&r)[32], int lane) {
    int q = it;
    if (q < I_IN)  { p0_ld<2048, 5120>(F.w_in, q / 160, q % 160, r, lane, F.norm_mix); return; } q -= I_IN;
    if (q < I_GLU) { p0_ld<1024, 1024>(F.w_glu, q / 32, q % 32, r, lane); return; } q -= I_GLU;
    if (q < I_OUT) { p0_ld<2048, 2048>(F.w_out, q / 64, q % 64, r, lane); return; } q -= I_OUT;
    if (q < I_FI)  { p0_ld<2048, 11264>(F.w_ffn_in, q / 352, q % 352, r, lane, F.norm_ffn); return; } q -= I_FI;
    p0_ld<5632, 2048>(F.w_ffn_out, q / 64, q % 64, r, lane);
}
__device__ __forceinline__ void p0_item_store(const Frame& F, int it, const float (&r)[32], LAS float* scr, int lane) {
    int q = it;
    if (q < I_IN)  { p0_st<2048>(F.WIN_T, q / 160, win_dest_row(32 * (q % 160)), r, scr, lane); return; } q -= I_IN;
    if (q < I_GLU) { p0_st<1024>(F.WGLU_T, q / 32, 32 * (q % 32), r, scr, lane); return; } q -= I_GLU;
    if (q < I_OUT) { p0_st<2048>(F.WOUT_T, q / 64, 32 * (q % 64), r, scr, lane); return; } q -= I_OUT;
    if (q < I_FI)  { p0_st<2048>(F.WFI_T, q / 352, wfi_dest_row(32 * (q % 352)), r, scr, lane); return; } q -= I_FI;
    p0_st<5632>(F.WFO_T, q / 64, 32 * (q % 64), r, scr, lane);
}
__device__ __forceinline__ void p0_convert_items(const Frame& F, int first, int last, int gw, int NGW, LAS float* scr) {
    float ra[32], rb[32];
    int it = first + gw;
    if (it < last) p0_item_load(F, it, ra, F.lane);
    for (; it < last; it += 2 * NGW) {
        const bool hb = it + NGW < last, ha = it + 2 * NGW < last;
        if (hb) p0_item_load(F, it + NGW, rb, F.lane);
        p0_item_store(F, it, ra, scr, F.lane);
        if (ha) p0_item_load(F, it + 2 * NGW, ra, F.lane);
        if (hb) p0_item_store(F, it + NGW, rb, scr, F.lane);
    }
}
__device__ __forceinline__ void s5_lambar(const Frame& F, int i  , float& cr, float& ci, double& fr, double& fi) {
    const float dt = (float)exp((double)F.log_step[i >> 6]);
    const float lr = F.lam_re[i], li = F.lam_im[i];
    const float are = __fmul_rn(lr, dt), aim = __fmul_rn(li, dt);
    const float er = (float)exp((double)are), cs = (float)cos((double)aim), sn = (float)sin((double)aim);
    cr = __fmul_rn(er, cs); ci = __fmul_rn(er, sn);
    const double nr = (double)cr - 1.0, ni = (double)ci, den = (double)lr * lr + (double)li * li;
    fr = (nr * lr + ni * li) / den; fi = (ni * lr - nr * li) / den;
}
__device__ __forceinline__ void s5_precompute(Frame& F, const int g) {
    LAS float* PW = (LAS float*)F.lds;
    LAS float* BBL = PW + 17 * 64 * 2;
    LAS float* KT = BBL + 64 * 16 * 2;
    LAS float* CL = KT + 4096;
    const int tid = F.tid, lane = F.lane, w = F.wave;
#pragma unroll
    for (int i = 0; i < 2; ++i) { const int q = tid + 512 * i; CL[2 * q] = F.c_re[g * 1024 + q]; CL[2 * q + 1] = F.c_im[g * 1024 + q]; }
    if (tid < 64) {
        const int p = tid; const float cr = F.LBR[g * 64 + p], ci = F.LBI[g * 64 + p];
        const double lr = F.lam_re[g * 64 + p], li = F.lam_im[g * 64 + p];
        const double nr = (double)cr - 1.0, ni = (double)ci, den = lr * lr + li * li;
        const double fr = (nr * lr + ni * li) / den, fi = (ni * lr - nr * li) / den;
        float ar = 1.f, ai = 0.f;
        for (int t = 0; t < 17; ++t) { PW[(t * 64 + p) * 2] = ar; PW[(t * 64 + p) * 2 + 1] = ai; const float nr2 = ar * cr - ai * ci, ni2 = ar * ci + ai * cr; ar = nr2; ai = ni2; }
        for (int h = 0; h < 16; ++h) { const double br = F.b_re[(g * 64 + p) * 16 + h], bi = F.b_im[(g * 64 + p) * 16 + h];
            BBL[(p * 16 + h) * 2] = (float)(fr * br - fi * bi); BBL[(p * 16 + h) * 2 + 1] = (float)(fr * bi + fi * br); }
    }
    __syncthreads();
    {
        float c_r[16], c_i[16], b_r[16], b_i[16];
#pragma unroll
        for (int ks = 0; ks < 16; ++ks) { const int p = 4 * ks + (lane >> 4);
            c_r[ks] = CL[(((lane & 15)) * 64 + p) * 2]; c_i[ks] = CL[(((lane & 15)) * 64 + p) * 2 + 1];
            b_r[ks] = BBL[(p * 16 + (lane & 15)) * 2]; b_i[ks] = BBL[(p * 16 + (lane & 15)) * 2 + 1]; }
#pragma unroll
        for (int tt = 0; tt < 2; ++tt) { const int tau = 2 * w + tt;
            f32x4 acc = {0.f, 0.f, 0.f, 0.f};
#pragma unroll
            for (int ks = 0; ks < 16; ++ks) { const int p = 4 * ks + (lane >> 4);
                const float wr_ = PW[(tau * 64 + p) * 2], wi_ = PW[(tau * 64 + p) * 2 + 1];
                const float cwr = c_r[ks] * wr_ - c_i[ks] * wi_, cwi = c_r[ks] * wi_ + c_i[ks] * wr_;
                acc = __builtin_amdgcn_mfma_f32_16x16x4f32(cwr, b_r[ks], acc, 0, 0, 0);
                acc = __builtin_amdgcn_mfma_f32_16x16x4f32(-cwi, b_i[ks], acc, 0, 0, 0); }
#pragma unroll
            for (int e = 0; e < 4; ++e) KT[(tau << 8) | ((4 * (lane >> 4) + e) << 4) | (lane & 15)] = acc[e];
        }
    }
    __syncthreads();
#pragma unroll 1
    for (int q = 0; q < 4; ++q) {
    {
        const int r = 64 * q + (tid >> 3), t = r >> 4, h = r & 15, cb = tid & 7;
        bf16* dst = F.S5Lm + ((size_t)g * 256 + r) * 256 + 32 * cb;
#pragma unroll
        for (int k = 0; k < 4; ++k) { float v[8];
#pragma unroll
            for (int e = 0; e < 8; ++e) { const int col = 8 * k + e, s_ = 2 * cb + (col >> 4), hp = col & 15;
                float x = (s_ <= t) ? KT[((t - s_) << 8) | (h << 4) | hp] : 0.f; if (s_ == t && hp == h) x += F.s5_d[16 * g + h]; v[e] = x; }
            v4u o; o.x = pk2(v[0], v[1]); o.y = pk2(v[2], v[3]); o.z = pk2(v[4], v[5]); o.w = pk2(v[6], v[7]);
            *(GAS v4u*)(dst + 8 * k) = o; }
    }
    {
        const int j = 32 * q + (tid >> 4), p = j >> 1, im = j & 1, s_ = tid & 15;
        const float wr_ = PW[((15 - s_) * 64 + p) * 2], wi_ = PW[((15 - s_) * 64 + p) * 2 + 1];
        bf16* dst = F.S5Hm + ((size_t)g * 128 + j) * 256 + 16 * s_;
#pragma unroll
        for (int k = 0; k < 2; ++k) { float v[8];
#pragma unroll
            for (int e = 0; e < 8; ++e) { const int hp = 8 * k + e; const float b_r = BBL[(p * 16 + hp) * 2], b_i = BBL[(p * 16 + hp) * 2 + 1];
                v[e] = im ? (wr_ * b_i + wi_ * b_r) : (wr_ * b_r - wi_ * b_i); }
            v4u o; o.x = pk2(v[0], v[1]); o.y = pk2(v[2], v[3]); o.z = pk2(v[4], v[5]); o.w = pk2(v[6], v[7]);
            *(GAS v4u*)(dst + 8 * k) = o; }
    }
    {
        const int r = 64 * q + (tid >> 3), t = r >> 4, h = r & 15, cb = tid & 7;
        bf16* dst = F.S5Gm + ((size_t)g * 256 + r) * 128 + 16 * cb;
#pragma unroll
        for (int k = 0; k < 2; ++k) { float v[8];
#pragma unroll
            for (int e = 0; e < 4; ++e) { const int p = 8 * cb + 4 * k + e;
                const float c_r = CL[(h * 64 + p) * 2], c_i = CL[(h * 64 + p) * 2 + 1];
                const float wr_ = PW[((t + 1) * 64 + p) * 2], wi_ = PW[((t + 1) * 64 + p) * 2 + 1];
                v[2 * e] = c_r * wr_ - c_i * wi_; v[2 * e + 1] = -(c_r * wi_ + c_i * wr_); }
            v4u o; o.x = pk2(v[0], v[1]); o.y = pk2(v[2], v[3]); o.z = pk2(v[4], v[5]); o.w = pk2(v[6], v[7]);
            *(GAS v4u*)(dst + 8 * k) = o; }
    }
    }
    __syncthreads();
}
__device__ __forceinline__ void p0_prologue(Frame& F) {
    LAS float* scr = (LAS float*)(F.lds + F.wave * 16384);
    const int gw = (int)blockIdx.x * NWAVES + F.wave, NGW = F.G * NWAVES;
    p0_convert_items(F, 0, NITEMS - I_FO + I_FO_P0, gw, NGW, scr);
    {
        f32x4 va[8], vb[8];
        int m = gw;
        if (m < MROWS) rms_row_load(xrow_ptr(F, m), va, F.lane);
        for (; m < MROWS; m += 2 * NGW) {
            const bool hb = m + NGW < MROWS, ha = m + 2 * NGW < MROWS;
            if (hb) rms_row_load(xrow_ptr(F, m + NGW), vb, F.lane);
            rms_row_finish(va, F.SS0 + m, F.XN + (size_t)m * 2048, F.lane);
            if (ha) rms_row_load(xrow_ptr(F, m + 2 * NGW), va, F.lane);
            if (hb) rms_row_finish(vb, F.SS0 + m + NGW, F.XN + (size_t)(m + NGW) * 2048, F.lane);
        }
    }
    const int gt = (int)blockIdx.x * (NWAVES * 64) + F.tid, NGT = F.G * NWAVES * 64;
    for (int i = gt; i < 4096; i += NGT) {
        const int g = i >> 6, p = i & 63;
        const float dt = (float)exp((double)F.log_step[g]);
        const float lr = F.lam_re[i], li = F.lam_im[i];
        const float are = __fmul_rn(lr, dt), aim = __fmul_rn(li, dt);
        const float er = (float)exp((double)are), cs = (float)cos((double)aim), sn = (float)sin((double)aim);
        const float cr = __fmul_rn(er, cs), ci = __fmul_rn(er, sn);
        F.LBR[i] = cr; F.LBI[i] = ci;
        const double nr = (double)cr - 1.0, ni = (double)ci, den = (double)lr * lr + (double)li * li;
        const double fr = (nr * lr + ni * li) / den, fi = (ni * lr - nr * li) / den;
        for (int h = 0; h < 16; ++h) {
            const double br = F.b_re[i * 16 + h], bi = F.b_im[i * 16 + h];
            F.BB[((size_t)g * 128 + 2 * p) * 16 + h] = (bf16)f2bf((float)(fr * br - fi * bi));
            F.BB[((size_t)g * 128 + 2 * p + 1) * 16 + h] = (bf16)f2bf((float)(fr * bi + fi * br));
            F.CMT[((size_t)g * 16 + h) * 128 + 2 * p] = (bf16)f2bf(F.c_re[(g * 16 + h) * 64 + p]);
            F.CMT[((size_t)g * 16 + h) * 128 + 2 * p + 1] = (bf16)f2bf(-F.c_im[(g * 16 + h) * 64 + p]);
        }
    }
    for (int i = gt; i < 2056 * 64; i += NGT) {
        const int pi = i >> 6, j = i & 63;
        const float pos = pi < 2048 ? (float)pi : 16384.f + (float)(pi - 2048);
        const float inv = (float)pow(10000.0, -(double)j / 64.0);
        const float ang = __fmul_rn(pos, inv);
        F.ROPEC[i] = (float)cos((double)ang); F.ROPES[i] = (float)sin((double)ang);
    }
}

constexpr int S5L_BU = 0, S5L_XS = 65536, S5L_EX = 98304;
__device__ __forceinline__ float gelu_tanh(float y) {
    const float c = 0.7978845608028654f * (y + 0.044715f * y * y * y);
    const float e = __expf(2.f * c);
    const float th = 1.f - 2.f * __builtin_amdgcn_rcpf(1.f + e);
    return 0.5f * y * (1.f + th);
}
template <int MODE>
__device__ __forceinline__ void s5_item(Frame& F, const int g, const int idx) {
    LAS unsigned char* lds = F.lds;
    const int lane = F.lane, w = F.wave, p = lane;
    const int rowbase = (MODE == 0) ? idx * 2048 : 8192 + idx * 128;
    const int nblk = (MODE == 0) ? 16 : 1;
    const float lr = F.LBR[g * 64 + p], li = F.LBI[g * 64 + p];
    const int tt = w >> 1, jt0 = 2 * (w & 1);
    bf16x8 bbf[2];
#pragma unroll
    for (int q = 0; q < 2; ++q) bbf[q] = *(const GAS bf16x8*)(F.BB + ((size_t)g * 128 + 32 * (jt0 + q) + (lane & 31)) * 16 + 8 * (lane >> 5));
    bf16x8 cf[4];
#pragma unroll
    for (int s = 0; s < 4; ++s) cf[s] = *(const GAS bf16x8*)(F.CMT + ((size_t)g * 16 + (lane & 15)) * 128 + 32 * s + 8 * (lane >> 4));
    const f32x4 dreg = *(const GAS f32x4*)(F.s5_d + 16 * g + 4 * (lane >> 4));
    float l16r = 1.f, l16i = 0.f;
    float pwr[16], pwi[16];
    if (MODE == 0) {
        float ar = lr, ai = li;
#pragma unroll
        for (int k = 0; k < 16; ++k) { pwr[k] = ar; pwi[k] = ai; const float nr = ar * lr - ai * li, ni = ar * li + ai * lr; ar = nr; ai = ni; }
        l16r = pwr[15]; l16i = pwi[15];
    }
    const int xlane = 16 * (p >> 2) + 4 * (p & 3);
    float Xr = 0.f, Xi = 0.f;
    bf16x8 uf = *(const GAS bf16x8*)(F.U + (size_t)(rowbase + 32 * tt + (lane & 31)) * 1024 + 16 * g + 8 * (lane >> 5));
    for (int blk = 0; blk < nblk; ++blk) {
        const int rb = rowbase + 128 * blk;
#pragma unroll
        for (int q = 0; q < 2; ++q) {
            f32x16 z;
#pragma unroll
            for (int e = 0; e < 16; ++e) z[e] = 0.f;
            const f32x16 d = __builtin_amdgcn_mfma_f32_32x32x16_bf16(uf, bbf[q], z, 0, 0, 0);
            const int j = 32 * (jt0 + q) + (lane & 31);
#pragma unroll
            for (int e = 0; e < 16; ++e) { const int t = 32 * tt + (e & 3) + 8 * (e >> 2) + 4 * (lane >> 5);
                *(LAS float*)(lds + S5L_BU + (t * 128 + j) * 4) = d[e]; }
        }
        if (blk + 1 < nblk) uf = *(const GAS bf16x8*)(F.U + (size_t)(rb + 128 + 32 * tt + (lane & 31)) * 1024 + 16 * g + 8 * (lane >> 5));
        const size_t r = (size_t)(rb + 16 * w + (lane & 15));
        const int h0 = 16 * g + 4 * (lane >> 4);
        const u32x2v uw = *(const GAS u32x2v*)(F.U + r * 1024 + h0);
        LDS_BARRIER();
        if (MODE == 0) {
            float locr[16], loci[16];
            f32x2v b[16];
#pragma unroll
            for (int k = 0; k < 16; ++k) b[k] = *(const LAS f32x2v*)(lds + S5L_BU + ((16 * w + k) * 128 + 2 * p) * 4);
            float xr = 0.f, xi = 0.f;
#pragma unroll
            for (int k = 0; k < 16; ++k) { const float nr = lr * xr - li * xi + b[k].x, ni = lr * xi + li * xr + b[k].y; xr = nr; xi = ni; locr[k] = xr; loci[k] = xi; }
            *(LAS f32x2v*)(lds + S5L_EX + (w * 64 + p) * 8) = (f32x2v){xr, xi};
            LDS_BARRIER();
            float cr = Xr, ci = Xi, Cwr = 0.f, Cwi = 0.f;
#pragma unroll
            for (int ww = 0; ww < 8; ++ww) {
                if (ww == w) { Cwr = cr; Cwi = ci; }
                const f32x2v e = *(const LAS f32x2v*)(lds + S5L_EX + (ww * 64 + p) * 8);
                const float nr = l16r * cr - l16i * ci + e.x, ni = l16r * ci + l16i * cr + e.y; cr = nr; ci = ni;
            }
            Xr = cr; Xi = ci;
#pragma unroll
            for (int k = 0; k < 16; ++k) {
                const float fr = locr[k] + pwr[k] * Cwr - pwi[k] * Cwi, fi = loci[k] + pwr[k] * Cwi + pwi[k] * Cwr;
                *(LAS unsigned*)(lds + S5L_XS + 4096 * w + 256 * k + (xlane ^ (16 * (((k & 3) << 2) | ((k >> 2) & 3)))) ) = cvtpk(fr, fi);
            }
        } else {
#pragma unroll
            for (int s2 = 0; s2 < 2; ++s2) {
                const int seq = 16 * idx + 2 * w + s2;
                float xr = F.st_re[((size_t)seq * 64 + g) * 64 + p], xi = F.st_im[((size_t)seq * 64 + g) * 64 + p];
#pragma unroll
                for (int k = 0; k < 8; ++k) {
                    const int tl = 16 * w + 8 * s2 + k;
                    const f32x2v b = *(const LAS f32x2v*)(lds + S5L_BU + (tl * 128 + 2 * p) * 4);
                    const float nr = lr * xr - li * xi + b.x, ni = lr * xi + li * xr + b.y; xr = nr; xi = ni;
                    *(LAS unsigned*)(lds + S5L_XS + 4096 * w + 256 * (8 * s2 + k) + (xlane ^ (16 * ((((8 * s2 + k) & 3) << 2) | (((8 * s2 + k) >> 2) & 3))))) = cvtpk(xr, xi);
                }
                F.o_s5re_s[((size_t)seq * 64 + g) * 64 + p] = xr; F.o_s5im_s[((size_t)seq * 64 + g) * 64 + p] = xi;
            }
        }
        LDS_BARRIER();
        f32x4 ya = {0.f, 0.f, 0.f, 0.f};
#pragma unroll
        for (int s = 0; s < 4; ++s) {
            const bf16x8 xf = *(const LAS bf16x8*)(lds + S5L_XS + offb(16 * w + (lane & 15), 4 * s + (lane >> 4)));
            ya = __builtin_amdgcn_mfma_f32_16x16x32_bf16(cf[s], xf, ya, 0, 0, 0);
        }
        const float y0 = gelu_tanh(ya[0] + dreg[0] * bflo(uw.x)), y1 = gelu_tanh(ya[1] + dreg[1] * bfhi(uw.x));
        const float y2 = gelu_tanh(ya[2] + dreg[2] * bflo(uw.y)), y3 = gelu_tanh(ya[3] + dreg[3] * bfhi(uw.y));
        u32x2v yo; yo.x = cvtpk(y0, y1); yo.y = cvtpk(y2, y3);
        *(GAS u32x2v*)(F.YS5 + r * 1024 + h0) = yo;
    }
    if (MODE == 0 && w == 0) { F.o_s5re_p[((size_t)idx * 64 + g) * 64 + p] = Xr; F.o_s5im_p[((size_t)idx * 64 + g) * 64 + p] = Xi; }
}

constexpr int S5G_UI = 0, S5G_HX = 65536;
__device__ __forceinline__ void s5_prompt_gemm(Frame& F, const int g, const int n) {
    LAS unsigned char* lds = F.lds;
    const int tid = F.tid, lane = F.lane, w = F.wave, p = lane;
    const size_t rowbase = (size_t)n * 2048;
#pragma unroll
    for (int i = 0; i < 8; ++i) { const int q = tid + 512 * i, token = q >> 1, half = q & 1, c = token >> 4, s_ = token & 15;
        const v4u v = *(const GAS v4u*)(F.U + (rowbase + token) * 1024 + 16 * g + 8 * half);
        *(LAS v4u*)(lds + S5G_UI + 512 * c + 16 * ((2 * s_ + half) ^ (c & 15))) = v; }
    bf16x8 hf[8];
#pragma unroll
    for (int s = 0; s < 8; ++s) hf[s] = *(const GAS bf16x8*)(F.S5Hm + ((size_t)g * 128 + 16 * w + (lane & 15)) * 256 + 32 * s + 8 * (lane >> 4));
    const float lr = F.LBR[g * 64 + p], li = F.LBI[g * 64 + p];
    LDS_BARRIER();
#pragma unroll 2
    for (int ct = 0; ct < 8; ++ct) {
        f32x4 a = {0.f, 0.f, 0.f, 0.f};
        const int c = 16 * ct + (lane & 15);
#pragma unroll
        for (int s = 0; s < 8; ++s) {
            const bf16x8 uf = *(const LAS bf16x8*)(lds + S5G_UI + 512 * c + 16 * ((4 * s + (lane >> 4)) ^ (lane & 15)));
            a = __builtin_amdgcn_mfma_f32_16x16x32_bf16(hf[s], uf, a, 0, 0, 0);
        }
        *(LAS f32x4*)(lds + S5G_HX + 512 * c + 4 * (16 * w + 4 * (lane >> 4))) = a;
    }
    const int t0 = w, t1 = 15 - w;
    bf16x8 l0[8], l1[8], g0[4], g1[4];
#pragma unroll
    for (int s = 0; s < 8; ++s) { l0[s] = *(const GAS bf16x8*)(F.S5Lm + ((size_t)g * 256 + 16 * t0 + (lane & 15)) * 256 + 32 * s + 8 * (lane >> 4));
                                  l1[s] = *(const GAS bf16x8*)(F.S5Lm + ((size_t)g * 256 + 16 * t1 + (lane & 15)) * 256 + 32 * s + 8 * (lane >> 4)); }
#pragma unroll
    for (int s = 0; s < 4; ++s) { g0[s] = *(const GAS bf16x8*)(F.S5Gm + ((size_t)g * 256 + 16 * t0 + (lane & 15)) * 128 + 32 * s + 8 * (lane >> 4));
                                  g1[s] = *(const GAS bf16x8*)(F.S5Gm + ((size_t)g * 256 + 16 * t1 + (lane & 15)) * 128 + 32 * s + 8 * (lane >> 4)); }
    LDS_BARRIER();
    if (w == 0) {
        float Lr = lr, Li = li;
#pragma unroll
        for (int k = 0; k < 4; ++k) { const float nr = Lr * Lr - Li * Li, ni = 2.f * Lr * Li; Lr = nr; Li = ni; }
        float xr = 0.f, xi = 0.f;
        const int xlane = 16 * (p >> 2) + 4 * (p & 3);
        for (int c8 = 0; c8 < 128; c8 += 8) {
            f32x2v b[8];
#pragma unroll
            for (int k = 0; k < 8; ++k) b[k] = *(const LAS f32x2v*)(lds + S5G_HX + 512 * (c8 + k) + 8 * p);
#pragma unroll
            for (int k = 0; k < 8; ++k) {
                const int cc = c8 + k;
                *(LAS unsigned*)(lds + S5G_HX + 256 * cc + (xlane ^ (16 * (((cc & 3) << 2) | ((cc >> 2) & 3))))) = cvtpk(xr, xi);
                const float nr = Lr * xr - Li * xi + b[k].x, ni = Lr * xi + Li * xr + b[k].y; xr = nr; xi = ni;
            }
        }
        F.o_s5re_p[((size_t)n * 64 + g) * 64 + p] = xr; F.o_s5im_p[((size_t)n * 64 + g) * 64 + p] = xi;
    }
    LDS_BARRIER();
#pragma unroll 1
    for (int ct = 0; ct < 8; ++ct) {
        f32x4 a0 = {0.f, 0.f, 0.f, 0.f}, a1 = {0.f, 0.f, 0.f, 0.f};
        const int c = 16 * ct + (lane & 15);
#pragma unroll
        for (int s = 0; s < 8; ++s) {
            const bf16x8 uf = *(const LAS bf16x8*)(lds + S5G_UI + 512 * c + 16 * ((4 * s + (lane >> 4)) ^ (lane & 15)));
            a0 = __builtin_amdgcn_mfma_f32_16x16x32_bf16(l0[s], uf, a0, 0, 0, 0);
            a1 = __builtin_amdgcn_mfma_f32_16x16x32_bf16(l1[s], uf, a1, 0, 0, 0);
        }
#pragma unroll
        for (int s = 0; s < 4; ++s) {
            const bf16x8 xf = *(const LAS bf16x8*)(lds + S5G_HX + offb(c, 4 * s + (lane >> 4)));
            a0 = __builtin_amdgcn_mfma_f32_16x16x32_bf16(g0[s], xf, a0, 0, 0, 0);
            a1 = __builtin_amdgcn_mfma_f32_16x16x32_bf16(g1[s], xf, a1, 0, 0, 0);
        }
        const int h0 = 16 * g + 4 * (lane >> 4);
        { u32x2v yo; yo.x = cvtpk(gelu_tanh(a0[0]), gelu_tanh(a0[1])); yo.y = cvtpk(gelu_tanh(a0[2]), gelu_tanh(a0[3]));
          *(GAS u32x2v*)(F.YS5 + (rowbase + 16 * c + t0) * 1024 + h0) = yo; }
        { u32x2v yo; yo.x = cvtpk(gelu_tanh(a1[0]), gelu_tanh(a1[1])); yo.y = cvtpk(gelu_tanh(a1[2]), gelu_tanh(a1[3]));
          *(GAS u32x2v*)(F.YS5 + (rowbase + 16 * c + t1) * 1024 + h0) = yo; }
    }
}

constexpr int RL_K = 0, RL_V = 65536, RL_P = 81920, RL_RT = 114688;
__device__ __forceinline__ void ret_prompt_item(Frame& F, const int n, const int h, const int part) {
    LAS unsigned char* lds = F.lds;
    const int tid = F.tid, lane = F.lane, w = F.wave;
    const float gam = 1.f - exp2f(-5.f - (float)h);
    const float cd = exp2f(128.f * __log2f(gam));
    LAS unsigned char* P = lds + RL_P + w * 4096;
#pragma unroll
    for (int i = 0; i < 4; ++i) *(LAS v4u*)(P + lane * 16 + i * 1024) = (v4u){0u, 0u, 0u, 0u};
    *(LAS v4u*)(lds + RL_RT + tid * 16) = (v4u){0u, 0u, 0u, 0u};
    const unsigned lq = (unsigned)(lane & 15) >> 2, lp = (unsigned)lane & 3u, lg = (unsigned)lane >> 4;
    const unsigned fl = ((unsigned)(lane & 3) << 2) | ((unsigned)(lane >> 2) & 3u);
    unsigned kx[4];
#pragma unroll
    for (int s = 0; s < 4; ++s) kx[s] = 256u * (unsigned)(lane & 15) + 16u * ((4u * s + lg) ^ fl);
    const unsigned pwbase = 256u * (unsigned)(lane & 15) + 8u * (lg & 1u), pl16 = 16u * (((unsigned)lane >> 5) ^ fl);
    const unsigned vb0 = lg * 256u + lq * 32u + lp * 8u, vh = (lg & 1u) * 128u;
    unsigned kso[4];
#pragma unroll
    for (int i = 0; i < 4; ++i) { const unsigned row = 4u * (4u * w + i) + lg, ch = (unsigned)(lane & 15) ^ ((lg << 2) | (unsigned)i); kso[i] = (row * 1024u + 8u * ch) * 2u; }
    const size_t rowbase = (size_t)n * 2048;
    const char* kbase = (const char*)(F.Kb + rowbase * 1024 + h * 128);
    const bf16* vsrc = F.V + (rowbase + ((tid >> 2) & 127)) * 1024 + h * 128 + 32 * part + 4 * (tid & 3);
    const unsigned vdst = (unsigned)((((tid >> 2) & 127) >> 3) * 256 + (((((tid >> 2) & 127) >> 2) & 1) ^ ((((tid >> 2) & 127) >> 3) & 1)) * 128 + ((tid >> 2) & 3) * 32 + (tid & 3) * 8);
    const bf16* qsrc = F.Q + (rowbase + 16 * w + (lane & 15)) * 1024 + h * 128 + 8 * lg;
    v4u kreg[4];
#define RP_KLOAD(c_) do { _Pragma("unroll") for (int _i = 0; _i < 4; ++_i) kreg[_i] = *(const GAS v4u*)(kbase + (size_t)(c_) * (128 * 1024 * 2) + kso[_i]); } while (0)
    RP_KLOAD(0);
    u32x2v vreg[2];
#pragma unroll
    for (int i = 0; i < 2; ++i) vreg[i] = *(const GAS u32x2v*)(vsrc + 16 * i);
    bf16x8 qn[4];
#pragma unroll
    for (int s = 0; s < 4; ++s) qn[s] = *(const GAS bf16x8*)(qsrc + 32 * s);
    f32x4 accR[2] = {{0.f, 0.f, 0.f, 0.f}, {0.f, 0.f, 0.f, 0.f}};
    u32x2v opend[2] = {{0u, 0u}, {0u, 0u}};
    for (int c = 0; c < 16; ++c) {
#pragma unroll
        for (int i = 0; i < 2; ++i) *(LAS u32x2v*)(lds + RL_V + (c & 1) * 8192 + i * 4096 + vdst) = vreg[i];
#pragma unroll
        for (int i = 0; i < 4; ++i) *(LAS v4u*)(lds + RL_K + (c & 1) * 32768 + (4 * w + i) * 1024 + lane * 16) = kreg[i];
        LDS_BARRIER();
        bf16x8 qf[4];
#pragma unroll
        for (int s = 0; s < 4; ++s) qf[s] = qn[s];
        if (c < 15) {
            RP_KLOAD(c + 1);
#pragma unroll
            for (int i = 0; i < 2; ++i) vreg[i] = *(const GAS u32x2v*)(vsrc + (size_t)(c + 1) * 128 * 1024 + 16 * i);
#pragma unroll
            for (int s = 0; s < 4; ++s) qn[s] = *(const GAS bf16x8*)(qsrc + (size_t)(c + 1) * 128 * 1024 + 32 * s);
        }
        asm volatile("" ::: "memory");
        if (c > 0) {
#pragma unroll
            for (int i = 0; i < 2; ++i) *(GAS u32x2v*)(F.Ob + (rowbase + 128 * (c - 1) + 16 * w + (lane & 15)) * 1024 + h * 128 + 32 * part + 16 * i + 4 * lg) = opend[i];
        }
        asm volatile("" ::: "memory");
        LAS unsigned char* KI = lds + RL_K + (c & 1) * 32768;
        LAS unsigned char* VI = lds + RL_V + (c & 1) * 8192;
        {
            bf16x8 kfc[4], kfn[4];
#pragma unroll
            for (int s = 0; s < 4; ++s) { kfc[s] = *(const LAS bf16x8*)(KI + kx[s]); kfn[s] = kfc[s]; }
            for (int cb = 0; cb <= w; ++cb) {
                if (cb < w) {
#pragma unroll
                    for (int s = 0; s < 4; ++s) kfn[s] = *(const LAS bf16x8*)(KI + 4096 * (cb + 1) + kx[s]);
                }
                f32x4 st = {0.f, 0.f, 0.f, 0.f};
#pragma unroll
                for (int s = 0; s < 4; ++s) st = __builtin_amdgcn_mfma_f32_16x16x32_bf16(kfc[s], qf[s], st, 0, 0, 0);
                if (cb == w) {
#pragma unroll
                    for (int e = 0; e < 4; ++e) if ((int)(4 * lg) + e > (lane & 15)) st[e] = 0.f;
                }
                u32x2v pw; pw.x = cvtpk(st[0], st[1]); pw.y = cvtpk(st[2], st[3]);
                *(LAS u32x2v*)(P + pwbase + ((32u * (unsigned)cb) ^ pl16)) = pw;
#pragma unroll
                for (int s = 0; s < 4; ++s) kfc[s] = kfn[s];
            }
        }
        bf16x8 kt[4];
#pragma unroll
        for (int s = 0; s < 4; ++s) { const unsigned r0 = 32 * s + 8 * lg + lq;
            kt[s] = tr_pair(KI, offb(r0, 2 * w + (lp >> 1)) + 8 * (lp & 1), offb(r0 + 4, 2 * w + (lp >> 1)) + 8 * (lp & 1)); }
        bf16x8 pf[4];
#pragma unroll
        for (int s = 0; s < 4; ++s) pf[s] = *(const LAS bf16x8*)(P + kx[s]);
#pragma unroll
        for (int i = 0; i < 2; ++i) {
            bf16x8 vf[4];
#pragma unroll
            for (int s = 0; s < 4; ++s) vf[s] = tr_pair(VI + i * 4096, 1024u * s + vb0 + vh, 1024u * s + vb0 + (vh ^ 128u));
            f32x4 oi = {0.f, 0.f, 0.f, 0.f}, oc = {0.f, 0.f, 0.f, 0.f};
#pragma unroll
            for (int s = 0; s < 4; ++s) {
                oi = __builtin_amdgcn_mfma_f32_16x16x32_bf16(vf[s], pf[s], oi, 0, 0, 0);
                const bf16x8 rf = *(const LAS bf16x8*)(lds + RL_RT + (c & 1) * 8192 + i * 4096 + kx[s]);
                oc = __builtin_amdgcn_mfma_f32_16x16x32_bf16(rf, qf[s], oc, 0, 0, 0);
            }
            accR[i] = accR[i] * cd;
#pragma unroll
            for (int s = 0; s < 4; ++s) accR[i] = __builtin_amdgcn_mfma_f32_16x16x32_bf16(kt[s], vf[s], accR[i], 0, 0, 0);
            { u32x2v rw; rw.x = cvtpk(accR[i][0], accR[i][1]); rw.y = cvtpk(accR[i][2], accR[i][3]);
              *(LAS u32x2v*)(lds + RL_RT + ((c + 1) & 1) * 8192 + i * 4096 + pwbase + ((32u * (unsigned)w) ^ pl16)) = rw; }
            { const f32x4 o = oi + oc * cd; opend[i].x = cvtpk(o[0], o[1]); opend[i].y = cvtpk(o[2], o[3]); }
        }
    }
#pragma unroll
    for (int i = 0; i < 2; ++i) *(GAS u32x2v*)(F.Ob + (rowbase + 128 * 15 + 16 * w + (lane & 15)) * 1024 + h * 128 + 32 * part + 16 * i + 4 * lg) = opend[i];
#undef RP_KLOAD
#pragma unroll
    for (int i = 0; i < 2; ++i)
#pragma unroll
        for (int e = 0; e < 4; ++e) F.o_ret_p[(((size_t)n * 8 + h) * 128 + 16 * w + 4 * lg + e) * 128 + 32 * part + 16 * i + (lane & 15)] = accR[i][e];
    LDS_BARRIER();
}

constexpr int SL_Q = 0, SL_K = 4096, SL_SC = 8192, SL_OCP = 8704;
__device__ __forceinline__ void ret_sample_item(Frame& F, const int n, const int h) {
    LAS unsigned char* lds = F.lds;
    const int tid = F.tid, e = tid & 127, dq = tid >> 7;
    const float gam = 1.f - exp2f(-5.f - (float)h), l2g = __log2f(gam);
    const size_t rbase = ((size_t)n * 8 + h) * 128 * 128;
    const int row0 = 8192 + 8 * n;
    float R[32];
#pragma unroll
    for (int dd = 0; dd < 32; ++dd) R[dd] = F.st_ret[rbase + (size_t)(32 * dq + dd) * 128 + e];
#pragma unroll
    for (int i = 0; i < 2; ++i) { const int q = tid + 512 * i, t = q >> 7, d = q & 127;
        const size_t o = (size_t)(row0 + t) * 1024 + h * 128 + d;
        *(LAS float*)(lds + SL_Q + q * 4) = bflo((unsigned)F.Q[o]);
        *(LAS float*)(lds + SL_K + q * 4) = bflo((unsigned)F.Kb[o]) * exp2f(l2g * (float)(7 - t)); }
    float v[8];
#pragma unroll
    for (int t = 0; t < 8; ++t) v[t] = bflo((unsigned)F.V[(size_t)(row0 + t) * 1024 + h * 128 + e]);
    LDS_BARRIER();
    if (tid < 64) { const int i = tid >> 3, j = tid & 7; float s = 0.f;
        if (j <= i) { for (int d = 0; d < 128; ++d) s += *(const LAS float*)(lds + SL_Q + (i * 128 + d) * 4) * *(const LAS float*)(lds + SL_K + (j * 128 + d) * 4); s *= exp2f(l2g * (float)(i - 7)); }
        *(LAS float*)(lds + SL_SC + tid * 4) = s; }
    float oc[8];
#pragma unroll
    for (int t = 0; t < 8; ++t) oc[t] = 0.f;
    const float g8 = exp2f(8.f * l2g);
#pragma unroll
    for (int d4 = 0; d4 < 8; ++d4) {
        f32x4 qv[8], kv[8];
#pragma unroll
        for (int t = 0; t < 8; ++t) { qv[t] = *(const LAS f32x4*)(lds + SL_Q + (t * 128 + 32 * dq + 4 * d4) * 4); kv[t] = *(const LAS f32x4*)(lds + SL_K + (t * 128 + 32 * dq + 4 * d4) * 4); }
#pragma unroll
        for (int k = 0; k < 4; ++k) {
            const int dd = 4 * d4 + k; const float r = R[dd]; float rn = g8 * r;
#pragma unroll
            for (int t = 0; t < 8; ++t) { oc[t] += qv[t][k] * r; rn += kv[t][k] * v[t]; }
            R[dd] = rn;
        }
        asm volatile("" ::: "memory");
    }
#pragma unroll
    for (int dd = 0; dd < 32; ++dd) F.o_ret_s[rbase + (size_t)(32 * dq + dd) * 128 + e] = R[dd];
#pragma unroll
    for (int t = 0; t < 8; ++t) *(LAS float*)(lds + SL_OCP + ((dq * 8 + t) * 128 + e) * 4) = oc[t];
    LDS_BARRIER();
#pragma unroll
    for (int k = 0; k < 2; ++k) { const int t = 2 * dq + k;
        float o = 0.f;
#pragma unroll
        for (int qq = 0; qq < 4; ++qq) o += *(const LAS float*)(lds + SL_OCP + ((qq * 8 + t) * 128 + e) * 4);
        o *= exp2f(l2g * (float)(t + 1));
#pragma unroll
        for (int j = 0; j < 8; ++j) if (j <= t) o += *(const LAS float*)(lds + SL_SC + (t * 8 + j) * 4) * v[j];
        F.Ob[(size_t)(row0 + t) * 1024 + h * 128 + e] = (bf16)f2bf(o); }
    LDS_BARRIER();
}

__device__ __forceinline__ void ret_norm_rows(Frame& F, int first, int stride) {
    const int lane = F.lane, col = (lane >> 3) * 128 + (lane & 7) * 16;
    f32x4 gw[4];
#pragma unroll
    for (int i = 0; i < 4; ++i) gw[i] = *(const GAS f32x4*)(F.gn_w + col + 4 * i);
    for (int r0 = first; r0 < MROWS; r0 += 2 * stride) {
        v4u ow[2][2], gv[2][2];
#pragma unroll
        for (int k = 0; k < 2; ++k) { const int r = r0 + k * stride;
            if (r < MROWS) {
#pragma unroll
                for (int i = 0; i < 2; ++i) { ow[k][i] = *(const GAS v4u*)(F.Ob + (size_t)r * 1024 + col + 8 * i); gv[k][i] = *(const GAS v4u*)(F.Gt + (size_t)r * 1024 + col + 8 * i); } } }
#pragma unroll
        for (int k = 0; k < 2; ++k) { const int r = r0 + k * stride;
            if (r < MROWS) {
                float x[16], g[16];
#pragma unroll
                for (int i = 0; i < 2; ++i)
#pragma unroll
                    for (int j = 0; j < 4; ++j) { x[8 * i + 2 * j] = bflo(ow[k][i][j]); x[8 * i + 2 * j + 1] = bfhi(ow[k][i][j]); g[8 * i + 2 * j] = bflo(gv[k][i][j]); g[8 * i + 2 * j + 1] = bfhi(gv[k][i][j]); }
                float s = 0.f;
#pragma unroll
                for (int j = 0; j < 16; ++j) s += x[j];
                s += __shfl_xor(s, 1); s += __shfl_xor(s, 2); s += __shfl_xor(s, 4);
                const float mu = s * (1.f / 128.f);
                float q = 0.f;
#pragma unroll
                for (int j = 0; j < 16; ++j) { x[j] -= mu; q += x[j] * x[j]; }
                q += __shfl_xor(q, 1); q += __shfl_xor(q, 2); q += __shfl_xor(q, 4);
                const float rs = rsqrtf(q * (1.f / 128.f) + 1e-6f);
                v4u o[2];
#pragma unroll
                for (int i = 0; i < 2; ++i)
#pragma unroll
                    for (int j = 0; j < 4; ++j) { const int e = 8 * i + 2 * j; o[i][j] = pk2(g[e] * (x[e] * rs * gw[e >> 2][e & 3]), g[e + 1] * (x[e + 1] * rs * gw[(e + 1) >> 2][(e + 1) & 3])); }
#pragma unroll
                for (int i = 0; i < 2; ++i) *(GAS v4u*)(F.MIX + (size_t)r * 2048 + 1024 + col + 8 * i) = o[i];
            } }
    }
}
__device__ __forceinline__ void sample_rows_reduce(Frame& F, const bf16* slab, float* ss) {
    const int gwv = (int)blockIdx.x * NWAVES + F.wave, NGW = F.G * NWAVES, lane = F.lane;
    for (int m = 8192 + gwv; m < MROWS; m += NGW) {
        const GAS v4u* xr = (const GAS v4u*)(F.XN + (size_t)m * 2048) + lane;
        f32x4 v[8]; float s = 0.f;
#pragma unroll
        for (int j = 0; j < 4; ++j) { const v4u w = xr[64 * j];
            v[2 * j] = (f32x4){bflo(w.x), bfhi(w.x), bflo(w.y), bfhi(w.y)}; v[2 * j + 1] = (f32x4){bflo(w.z), bfhi(w.z), bflo(w.w), bfhi(w.w)}; }
#pragma unroll 2
        for (int k = 0; k < 4; ++k) {
            const GAS v4u* sr = (const GAS v4u*)(slab + ((size_t)k * 1024 + (m - 8192)) * 2048) + lane;
#pragma unroll
            for (int j = 0; j < 4; ++j) { const v4u w = sr[64 * j];
                v[2 * j] += (f32x4){bflo(w.x), bfhi(w.x), bflo(w.y), bfhi(w.y)}; v[2 * j + 1] += (f32x4){bflo(w.z), bfhi(w.z), bflo(w.w), bfhi(w.w)}; }
        }
        GAS v4u* o16 = (GAS v4u*)(F.XN + (size_t)m * 2048) + lane;
#pragma unroll
        for (int j = 0; j < 4; ++j) { const f32x4 a = v[2 * j], c = v[2 * j + 1];
            s += ((a.x * a.x + a.y * a.y) + (a.z * a.z + a.w * a.w)) + ((c.x * c.x + c.y * c.y) + (c.z * c.z + c.w * c.w));
            v4u o; o.x = pk2(a.x, a.y); o.y = pk2(a.z, a.w); o.z = pk2(c.x, c.y); o.w = pk2(c.z, c.w); o16[64 * j] = o; }
        s = wave_sum(s);
        if (lane == 0) ss[m] = s;
    }
}
__device__ __forceinline__ void final_norm(Frame& F, const bf16* slab) {
    const int gwv = (int)blockIdx.x * NWAVES + F.wave, NGW = F.G * NWAVES, lane = F.lane;
    for (int m = gwv; m < MROWS; m += NGW) {
        const GAS v4u* xr = (const GAS v4u*)(F.XN + (size_t)m * 2048) + lane;
        f32x4 v[8];
#pragma unroll
        for (int j = 0; j < 4; ++j) { const v4u w = xr[64 * j];
            v[2 * j] = (f32x4){bflo(w.x), bfhi(w.x), bflo(w.y), bfhi(w.y)}; v[2 * j + 1] = (f32x4){bflo(w.z), bfhi(w.z), bflo(w.w), bfhi(w.w)}; }
        if (m >= 8192) {
#pragma unroll 2
            for (int k = 0; k < 8; ++k) {
                const GAS v4u* sr = (const GAS v4u*)(slab + ((size_t)k * 1024 + (m - 8192)) * 2048) + lane;
#pragma unroll
                for (int j = 0; j < 4; ++j) { const v4u w = sr[64 * j];
                    v[2 * j] += (f32x4){bflo(w.x), bfhi(w.x), bflo(w.y), bfhi(w.y)}; v[2 * j + 1] += (f32x4){bflo(w.z), bfhi(w.z), bflo(w.w), bfhi(w.w)}; }
            }
        }
        float s = 0.f;
#pragma unroll
        for (int j = 0; j < 8; ++j) s += (v[j].x * v[j].x + v[j].y * v[j].y) + (v[j].z * v[j].z + v[j].w * v[j].w);
        const float sc = rsqrtf(wave_sum(s) * (1.f / 2048.f) + 1e-6f);
        GAS f32x4* yr = (GAS f32x4*)(F.Y + (size_t)m * 2048) + 2 * lane;
        const GAS f32x4* gr = (const GAS f32x4*)F.norm_final + 2 * lane;
#pragma unroll
        for (int j = 0; j < 4; ++j) { yr[128 * j] = v[2 * j] * sc * gr[128 * j]; yr[128 * j + 1] = v[2 * j + 1] * sc * gr[128 * j + 1]; }
    }
}

struct Args { const float* in[23]; float* out; unsigned char* ws; int ph_lo, ph_hi, li, pad; };
__global__ void __launch_bounds__(NWAVES * 64, 2) mk_fwd(Args args) {
    extern __shared__ __attribute__((aligned(16))) unsigned char lds[];
    Frame F;
    F.lds = (LAS unsigned char*)lds;
    F.MISC = (volatile LAS unsigned*)(F.lds + MISC_OFF);
    F.tid = threadIdx.x; F.lane = F.tid & 63; F.wave = __builtin_amdgcn_readfirstlane(F.tid >> 6);
    F.G = gridDim.x;
    unsigned char* ws = args.ws;
    F.ctl = (gu32*)(ws + WS_CTL);
    F.x_prompt = args.in[0]; F.x_sample = args.in[1]; F.st_re = args.in[2]; F.st_im = args.in[3]; F.st_ret = args.in[4]; F.norm_mix = args.in[5]; F.w_in = args.in[6];
    F.lam_re = args.in[7]; F.lam_im = args.in[8]; F.log_step = args.in[9]; F.b_re = args.in[10]; F.b_im = args.in[11]; F.c_re = args.in[12]; F.c_im = args.in[13];
    F.s5_d = args.in[14]; F.w_glu = args.in[15]; F.b_glu = args.in[16]; F.gn_w = args.in[17]; F.w_out = args.in[18]; F.norm_ffn = args.in[19]; F.w_ffn_in = args.in[20];
    F.w_ffn_out = args.in[21]; F.norm_final = args.in[22];
    F.Y = args.out;
    F.o_s5re_p = F.Y + (size_t)MROWS * 2048; F.o_s5im_p = F.o_s5re_p + 4 * 64 * 64; F.o_ret_p = F.o_s5im_p + 4 * 64 * 64;
    F.o_s5re_s = F.o_ret_p + (size_t)4 * 8 * 128 * 128; F.o_s5im_s = F.o_s5re_s + (size_t)128 * 64 * 64; F.o_ret_s = F.o_s5im_s + (size_t)128 * 64 * 64;
    F.LBR = (float*)(ws + WS_PAR); F.LBI = F.LBR + 4096; F.ROPEC = F.LBI + 4096; F.ROPES = F.ROPEC + 2056 * 64;
    F.SS0 = (float*)(ws + WS_PAR + 1736704);
    F.BB = (bf16*)(ws + WS_PAR + 1179648); F.CMT = F.BB + 64 * 128 * 16;
    F.WIN_T = (bf16*)(ws + WS_WIN); F.WGLU_T = (bf16*)(ws + WS_WGLU); F.WOUT_T = (bf16*)(ws + WS_WOUT); F.WFI_T = (bf16*)(ws + WS_WFI); F.WFO_T = (bf16*)(ws + WS_WFO);
    F.XN = (bf16*)(ws + WS_XN); F.U = (bf16*)(ws + WS_U); F.Q = (bf16*)(ws + WS_Q); F.Kb = (bf16*)(ws + WS_K); F.V = (bf16*)(ws + WS_V); F.Gt = (bf16*)(ws + WS_G);
    F.S5Lm = (bf16*)(ws + WS_S5L); F.S5Hm = (bf16*)(ws + WS_S5H); F.S5Gm = (bf16*)(ws + WS_S5G);
    F.Ob = (bf16*)(ws + WS_O); F.YS5 = (bf16*)(ws + WS_YS5); F.MIX = (bf16*)(ws + WS_MIX); F.ACT = (bf16*)(ws + WS_ACT);
    for (int u = F.tid; u < (LDS_BYTES - LDSCTL_OFF) / 4; u += NWAVES * 64) ((LAS unsigned*)(F.lds + LDSCTL_OFF))[u] = 0u;
    __syncthreads();
    XcdBarrier bar; bar.bar = (unsigned*)(F.ctl + CW_BAR); bar.x = 0; bar.st = nullptr;
    if (N_LAUNCHES == 1) bar = xcd_barrier_post((unsigned*)(F.ctl + CW_BAR), F.MISC + 8);
#define GRID_BAR() do { if (N_LAUNCHES == 1) xcd_barrier(bar); } while (0)
    const int lo = args.ph_lo, hi = args.ph_hi;
#define IN(k) (lo <= (k) && (k) < hi)
#define BOTH(k) (IN(k) && IN((k) + 1))
    const int bx = (int)blockIdx.x;

    if (IN(0)) { p0_prologue(F); if (BOTH(0)) GRID_BAR(); }

    if (IN(1)) {
        pg8::Gemm g{F.XN, F.WIN_T, MROWS, 5120, 2048}; pg8::StaticOrder S; S.init(MROWS, 5120, 2048, F.G, bx);
        pg8::EpiProj E{F.U, F.ROPEC, F.ROPES, F.SS0};
        pg8::gemm_phase<pg8::EpiProj, pg8::StaticOrder, PG8_ALIGN, PG8_SP2>(F.lds, g, S, E);
        {
            const int nlast = 720 - (720 / F.G) * F.G, nfree = F.G - nlast;
            __syncthreads();
            if (nlast == 0 || nfree <= 0) { for (int gg = bx; gg < 64; gg += F.G) s5_precompute(F, gg); }
            else if (bx >= nlast) { for (int gg = bx - nlast; gg < 64; gg += nfree) s5_precompute(F, gg); }
        }
        if (BOTH(1)) GRID_BAR();
    }

    if (IN(2)) {
        __syncthreads();
        for (int it = bx; it < 256; it += F.G) { s5_prompt_gemm(F, ((it & 7) << 3) | ((it >> 3) & 7), it >> 6); __syncthreads(); }
        for (int it = bx; it < 512; it += F.G) { s5_item<1>(F, ((it & 7) << 3) | ((it >> 3) & 7), it >> 6); __syncthreads(); }
        if (F.G == 256) {
            const int grpB = (bx >> 3) & 1, idx = (bx >> 4) * 8 + (bx & 7);
            if (!grpB) { const int xcd = idx & 7, slot = idx >> 3, part = slot & 3, nh = xcd + 8 * (slot >> 2);
                ret_prompt_item(F, nh >> 3, nh & 7, part); __syncthreads();
                ret_sample_item(F, idx >> 3, idx & 7); }
            else { for (int k = 0; k < 7; ++k) { const int it = 128 + idx + 128 * k; ret_sample_item(F, it >> 3, it & 7); } }
        } else {
            for (int it = bx; it < 128; it += F.G) { const int xcd = it & 7, slot = it >> 3, part = slot & 3, nh = xcd + 8 * (slot >> 2); ret_prompt_item(F, nh >> 3, nh & 7, part); __syncthreads(); }
            for (int it = bx; it < 1024; it += F.G) ret_sample_item(F, it >> 3, it & 7);
        }
        if (BOTH(2)) GRID_BAR();
    }

    if (IN(3)) {
        pg8::StaticOrder S; S.init(MROWS, 1024, 1024, F.G, bx);
        pg8::Unit u0;
        if (S.next(0, u0)) {
            pg8::Gemm g{F.YS5, F.WGLU_T, MROWS, 1024, 1024};
            pg8::EpiGlu E{F.YS5, F.MIX, F.b_glu};
            pg8::gemm_phase<pg8::EpiGlu, pg8::StaticOrder, PG8_ALIGN, PG8_SP2>(F.lds, g, S, E);
        } else {
            const int nfree = F.G - 144;
            ret_norm_rows(F, (bx - 144) * NWAVES + F.wave, nfree * NWAVES);
            p0_convert_items(F, NITEMS - I_FO + I_FO_P0, NITEMS, (bx - 144) * NWAVES + F.wave, nfree * NWAVES, (LAS float*)(F.lds + F.wave * 16384));
        }
        if (F.G <= 144) { ret_norm_rows(F, bx * NWAVES + F.wave, F.G * NWAVES); p0_convert_items(F, NITEMS - I_FO + I_FO_P0, NITEMS, bx * NWAVES + F.wave, F.G * NWAVES, (LAS float*)(F.lds + F.wave * 16384)); }
        if (BOTH(3)) GRID_BAR();
    }

    if (IN(4)) {
        pg8::Gemm g{F.MIX, F.WOUT_T, MROWS, 2048, 2048}; pg8::SplitOrder S; S.init(2048, F.G, bx);
        pg8::EpiResid<0> E{F.XN, (bf16*)(ws + WS_SLAB4), (float*)(ws + WS_SS)};
        pg8::gemm_phase<pg8::EpiResid<0>, pg8::SplitOrder, PG8_ALIGN, PG8_SP2>(F.lds, g, S, E);
        if (BOTH(4)) GRID_BAR();
    }
    if (IN(5)) { sample_rows_reduce(F, (const bf16*)(ws + WS_SLAB4), (float*)(ws + WS_SS)); if (BOTH(5)) GRID_BAR(); }
    if (IN(6)) {
        pg8::Gemm g{F.XN, F.WFI_T, MROWS, 11264, 2048}; pg8::HalfTailOrder S; S.init(MROWS, 11264, 2048, F.G, bx);
        pg8::EpiSwiglu E{F.ACT, 5632, (const float*)(ws + WS_SS)};
        pg8::gemm_phase<pg8::EpiSwiglu, pg8::HalfTailOrder, PG8_ALIGN, PG8_SP2>(F.lds, g, S, E);
        if (BOTH(6)) GRID_BAR();
    }
    if (IN(7)) {
        pg8::Gemm g{F.ACT, F.WFO_T, MROWS, 2048, 5632}; pg8::SplitOrder S; S.init(5632, F.G, bx);
        pg8::EpiResid<1> E{F.XN, (bf16*)(ws + WS_SLAB7), nullptr};
        pg8::gemm_phase<pg8::EpiResid<1>, pg8::SplitOrder, PG8_ALIGN, PG8_SP2>(F.lds, g, S, E);
        if (BOTH(7)) GRID_BAR();
    }
    if (IN(8)) final_norm(F, (const bf16*)(ws + WS_SLAB7));
#undef IN
#undef BOTH
}

extern "C" void kernel_launch(void* const* d_in, const int* in_sizes, int n_in, void* d_out, int out_size, void* d_ws, size_t ws_size, hipStream_t stream) {
    static int grid = 0;
    if (grid == 0) {
        if (n_in != 23 || ws_size < WS_END) { fprintf(stderr, "kernel_launch: expected 23 inputs and >= %zu bytes of workspace (got %d, %zu)\n", (size_t)WS_END, n_in, ws_size); grid = -1; return; }
        int dev = 0, cus = 0, per_cu = 0;
        if (hipGetDevice(&dev) != hipSuccess || hipDeviceGetAttribute(&cus, hipDeviceAttributeMultiprocessorCount, dev) != hipSuccess) { grid = -1; return; }
        if (hipFuncSetAttribute((const void*)mk_fwd, hipFuncAttributeMaxDynamicSharedMemorySize, LDS_BYTES) != hipSuccess) { fprintf(stderr, "kernel_launch: hipFuncSetAttribute failed\n"); grid = -1; return; }
        if (hipOccupancyMaxActiveBlocksPerMultiprocessor(&per_cu, (const void*)mk_fwd, NWAVES * 64, LDS_BYTES) != hipSuccess || per_cu < 1) { fprintf(stderr, "kernel_launch: occupancy query says %d blocks per CU\n", per_cu); grid = -1; (void)hipGetLastError(); return; }
        grid = cus;
        if (cus != 256) fprintf(stderr, "kernel_launch: built for a 256-CU device (static unit orders, split-K slices); this device reports %d CUs: the output will be wrong\n", cus);
    }
    if (grid < 0) return;
    if (hipMemsetAsync((char*)d_ws + WS_CTL, 0, CTL_ZERO_BYTES, stream) != hipSuccess) return;
    Args a{};
    for (int i = 0; i < 23; ++i) a.in[i] = (const float*)d_in[i];
    a.out = (float*)d_out; a.ws = (unsigned char*)d_ws;
    for (int li = 0; li < N_LAUNCHES; ++li) {
        a.ph_lo = (N_LAUNCHES == 1) ? 0 : li; a.ph_hi = (N_LAUNCHES == 1) ? N_PHASES : li + 1; a.li = li;
        void* kargs[] = {&a};
        hipError_t le = hipLaunchCooperativeKernel((const void*)mk_fwd, dim3(grid), dim3(NWAVES * 64), kargs, LDS_BYTES, stream);
        if (le != hipSuccess) { fprintf(stderr, "kernel_launch: launch %d failed: %s\n", li, hipGetErrorName(le)); break; }
    }
}
```
